# Optimizing an MI355X kernel written in HIP

```python
import jax, jax.numpy as jnp
from jax import lax
import numpy as np

D_MODEL = 1024
BATCH = 16
SEQ = 4096
DEPTH = 1

HEAD_DIM = 64
NSA_HEADS = 8
NSA_KV_GROUPS = 2
NSA_HPG = NSA_HEADS // NSA_KV_GROUPS
NSA_WIDTH = NSA_HEADS * HEAD_DIM
NSA_KV_WIDTH = NSA_KV_GROUPS * HEAD_DIM
CMP_LEN = 32
CMP_STRIDE = 16
CMP_HIDDEN = 2 * HEAD_DIM
SLC_BLOCK = 64
SLC_TOPN = 16
WINDOW = 512
MOBA_HEADS = 8
MOBA_WIDTH = MOBA_HEADS * HEAD_DIM
MOBA_BLOCK = 256
MOBA_TOPK = 3
TOTAL_HEADS = NSA_HEADS + MOBA_HEADS
Q_CHUNK = 32
RMS_EPS = 1e-6
COL_WIDTHS = (NSA_WIDTH, 6 * NSA_KV_WIDTH, 3 * NSA_HEADS, NSA_WIDTH, 3 * MOBA_WIDTH, MOBA_WIDTH, 2 * D_MODEL)
IN_COLS = NSA_WIDTH + 6 * NSA_KV_WIDTH + 3 * NSA_HEADS + NSA_WIDTH + 3 * MOBA_WIDTH + MOBA_WIDTH + 2 * D_MODEL

kernel_name = 'hybrid_nsa_moba_gated_block'


def rms_norm(x, g):
    xf = x.astype(jnp.float32)
    y = xf * lax.rsqrt(jnp.mean(xf * xf, axis=-1, keepdims=True) + RMS_EPS)
    return (y * g.astype(jnp.float32)).astype(x.dtype)


def alibi_slopes(n):
    return jnp.asarray((2.0 ** (-8.0 * np.arange(1, n + 1) / n)).astype(np.float32))


def masked_softmax(s, mask):
    s = jnp.where(mask, s, -jnp.inf)
    m = jnp.max(s, axis=-1, keepdims=True)
    m = jnp.where(jnp.isfinite(m), m, 0.0)
    p = jnp.where(mask, jnp.exp(s - m), 0.0)
    return p / jnp.maximum(jnp.sum(p, axis=-1, keepdims=True), 1e-30)


def cmp_to_slc_matrix(n_cmp, n_slc):
    cs = np.arange(n_cmp) * CMP_STRIDE
    ce = cs + CMP_LEN - 1
    ss = np.arange(n_slc) * SLC_BLOCK
    se = ss + SLC_BLOCK - 1
    return ((cs[:, None] <= se[None, :]) & (ce[:, None] >= ss[None, :])).astype(np.float32)


def compress(k, pe, w1, w2):
    S = k.shape[2]
    n_cmp = (S - CMP_LEN) // CMP_STRIDE + 1
    idx = np.arange(n_cmp)[:, None] * CMP_STRIDE + np.arange(CMP_LEN)[None, :]
    blocks = k[:, :, idx] + pe
    h = jax.nn.silu(jnp.einsum('bgnld,lde->bgne', blocks, w1))
    return jnp.einsum('bgne,ef->bgnf', h, w2)


def nsa_attention(q, kc, vc, ks, vs, kw, vw, gates, slopes):
    B, G, P, S, hd = q.shape
    n_cmp = kc.shape[2]
    n_slc = S // SLC_BLOCK
    k_sel = min(SLC_TOPN, n_slc)
    scale = hd ** -0.5
    cmp_end = jnp.asarray(np.arange(n_cmp) * CMP_STRIDE + CMP_LEN - 1, jnp.int32)
    overlap = jnp.asarray(cmp_to_slc_matrix(n_cmp, n_slc))
    ks_b = ks.reshape(B, G, n_slc, SLC_BLOCK, hd)
    vs_b = vs.reshape(B, G, n_slc, SLC_BLOCK, hd)
    kw_p = jnp.pad(kw, ((0, 0), (0, 0), (WINDOW, 0), (0, 0)))
    vw_p = jnp.pad(vw, ((0, 0), (0, 0), (WINDOW, 0), (0, 0)))
    bi = jnp.arange(B)[:, None, None, None]
    gi = jnp.arange(G)[None, :, None, None]
    blk = jnp.arange(n_slc)
    in_blk = jnp.arange(SLC_BLOCK)
    win_off = jnp.arange(WINDOW + Q_CHUNK) - WINDOW
    sl = slopes.astype(jnp.float32)[None, :, :, None, None]

    def chunk(ci):
        c0 = ci * Q_CHUNK
        t = c0 + jnp.arange(Q_CHUNK)
        qc = lax.dynamic_slice_in_dim(q, c0, Q_CHUNK, axis=3)
        g = lax.dynamic_slice_in_dim(gates, c0, Q_CHUNK, axis=4)
        dist = t[:, None] - cmp_end[None, :]
        s = jnp.einsum('bgpqd,bgnd->bgpqn', qc, kc).astype(jnp.float32) * scale - sl * dist.astype(jnp.float32)
        p_cmp = masked_softmax(s, dist >= 0)
        o_cmp = jnp.einsum('bgpqn,bgnd->bgpqd', p_cmp.astype(vc.dtype), vc)
        imp = jnp.einsum('bgpqn,nj->bgqj', p_cmp, overlap)
        cur = t // SLC_BLOCK
        causal_blk = blk[None, :] <= cur[:, None]
        forced = (blk[None, :] == 0) | (blk[None, :] == cur[:, None]) | (blk[None, :] == cur[:, None] - 1)
        imp = jnp.where(forced, jnp.inf, imp)
        imp = jnp.where(causal_blk, imp, -jnp.inf)
        _, sel = lax.top_k(imp, k_sel)
        kg = ks_b[bi, gi, sel]
        vg = vs_b[bi, gi, sel]
        pos = (sel[..., None] * SLC_BLOCK + in_blk).reshape(B, G, 1, Q_CHUNK, k_sel * SLC_BLOCK)
        dist = t[:, None] - pos
        s = jnp.einsum('bgpqd,bgqkld->bgpqkl', qc, kg).reshape(B, G, P, Q_CHUNK, k_sel * SLC_BLOCK)
        s = s.astype(jnp.float32) * scale - sl * dist.astype(jnp.float32)
        p = masked_softmax(s, dist >= 0).astype(vg.dtype).reshape(B, G, P, Q_CHUNK, k_sel, SLC_BLOCK)
        o_slc = jnp.einsum('bgpqkl,bgqkld->bgpqd', p, vg)
        kwin = lax.dynamic_slice_in_dim(kw_p, c0, WINDOW + Q_CHUNK, axis=2)
        vwin = lax.dynamic_slice_in_dim(vw_p, c0, WINDOW + Q_CHUNK, axis=2)
        posw = c0 + win_off
        dist = t[:, None] - posw[None, :]
        mask = (posw[None, :] >= 0) & (dist >= 0) & (dist < WINDOW)
        s = jnp.einsum('bgpqd,bgkd->bgpqk', qc, kwin).astype(jnp.float32) * scale - sl * dist.astype(jnp.float32)
        p = masked_softmax(s, mask).astype(vwin.dtype)
        o_win = jnp.einsum('bgpqk,bgkd->bgpqd', p, vwin)
        return g[0][..., None] * o_cmp + g[1][..., None] * o_slc + g[2][..., None] * o_win

    out = lax.map(chunk, jnp.arange(S // Q_CHUNK))
    return out.transpose(1, 0, 4, 2, 3, 5).reshape(B, S, G * P * hd)


def moba_attention(q, k, v, slopes):
    B, H, S, hd = q.shape
    nb = -(-S // MOBA_BLOCK)
    pad = nb * MOBA_BLOCK - S
    kb = jnp.pad(k, ((0, 0), (0, 0), (0, pad), (0, 0))).reshape(B, H, nb, MOBA_BLOCK, hd)
    vb = jnp.pad(v, ((0, 0), (0, 0), (0, pad), (0, 0))).reshape(B, H, nb, MOBA_BLOCK, hd)
    kbar = jnp.mean(kb.astype(jnp.float32), axis=3)
    k_sel = min(MOBA_TOPK, nb)
    scale = hd ** -0.5
    bi = jnp.arange(B)[:, None, None, None]
    hi = jnp.arange(H)[None, :, None, None]
    offs = jnp.arange(MOBA_BLOCK)
    blocks = jnp.arange(nb)
    sl = slopes.astype(jnp.float32)[None, :, None, None]

    def chunk(ci):
        c0 = ci * Q_CHUNK
        t = c0 + jnp.arange(Q_CHUNK)
        cur = c0 // MOBA_BLOCK
        qc = lax.dynamic_slice_in_dim(q, c0, Q_CHUNK, axis=2)
        gate = jnp.einsum('bhqd,bhnd->bhqn', qc.astype(jnp.float32), kbar)
        gate = jnp.where(blocks < cur, gate, -jnp.inf)
        _, sel = lax.top_k(gate, k_sel)
        valid = sel < cur
        kg = kb[bi, hi, sel]
        vg = vb[bi, hi, sel]
        ko = lax.dynamic_index_in_dim(kb, cur, axis=2, keepdims=False)
        vo = lax.dynamic_index_in_dim(vb, cur, axis=2, keepdims=False)
        n_sel = k_sel * MOBA_BLOCK
        s_sel = jnp.einsum('bhqd,bhqkld->bhqkl', qc, kg).reshape(B, H, Q_CHUNK, n_sel)
        s_own = jnp.einsum('bhqd,bhld->bhql', qc, ko)
        s = jnp.concatenate([s_sel, s_own], axis=-1).astype(jnp.float32) * scale
        pos_sel = (sel[..., None] * MOBA_BLOCK + offs).reshape(B, H, Q_CHUNK, n_sel)
        pos_own = jnp.broadcast_to(cur * MOBA_BLOCK + offs, (B, H, Q_CHUNK, MOBA_BLOCK))
        pos = jnp.concatenate([pos_sel, pos_own], axis=-1)
        dist = t[:, None] - pos
        mask_sel = jnp.broadcast_to(valid[..., None], (B, H, Q_CHUNK, k_sel, MOBA_BLOCK)).reshape(B, H, Q_CHUNK, n_sel)
        mask = jnp.concatenate([mask_sel, dist[..., n_sel:] >= 0], axis=-1)
        s = s - sl * dist.astype(jnp.float32)
        p = masked_softmax(s, mask).astype(v.dtype)
        p_sel = p[..., :n_sel].reshape(B, H, Q_CHUNK, k_sel, MOBA_BLOCK)
        p_own = p[..., n_sel:]
        return jnp.einsum('bhqkl,bhqkld->bhqd', p_sel, vg) + jnp.einsum('bhql,bhld->bhqd', p_own, vo)

    out = lax.map(chunk, jnp.arange(S // Q_CHUNK))
    return out.transpose(1, 0, 3, 2, 4).reshape(B, S, H * hd)


def hybrid_layer(x, norm_pre, w_in, pe_k, w1_k, w2_k, pe_v, w1_v, w2_v, w_a, w_b, w_o, norm_post):
    B, S, _ = x.shape
    G, P, hd = NSA_KV_GROUPS, NSA_HPG, HEAD_DIM
    u = rms_norm(x, norm_pre)
    proj = u @ w_in
    splits = [int(c) for c in np.cumsum(COL_WIDTHS)[:-1]]
    q_a, kv_a, g_a, z_a, qkv_b, z_b, merge = jnp.split(proj, splits, axis=-1)
    slopes = alibi_slopes(TOTAL_HEADS)
    q_a = q_a.reshape(B, S, G, P, hd).transpose(0, 2, 3, 1, 4)
    kv_a = kv_a.reshape(B, S, 6, G, hd).transpose(2, 0, 3, 1, 4)
    kc = compress(kv_a[0], pe_k, w1_k, w2_k)
    vc = compress(kv_a[1], pe_v, w1_v, w2_v)
    gates_a = jax.nn.sigmoid(g_a).reshape(B, S, 3, G, P).transpose(2, 0, 3, 4, 1)
    o_a = nsa_attention(q_a, kc, vc, kv_a[2], kv_a[3], kv_a[4], kv_a[5], gates_a,
                        slopes[0::2].reshape(G, P))
    y_a = o_a * jax.nn.silu(z_a)
    qkv_b = qkv_b.reshape(B, S, 3, MOBA_HEADS, hd).transpose(2, 0, 3, 1, 4)
    o_b = moba_attention(qkv_b[0], qkv_b[1], qkv_b[2], slopes[1::2])
    y_b = o_b * jax.nn.silu(z_b)
    gate_a, gate_b = jnp.split(merge, 2, axis=-1)
    m = jax.nn.sigmoid(gate_a) * (y_a @ w_a) + jax.nn.sigmoid(gate_b) * (y_b @ w_b)
    return x + rms_norm(m @ w_o, norm_post)


def setup_inputs(seed: int = 0) -> dict:
    key = jax.random.key(seed)
    ks = jax.random.split(key, 13)

    def nrm(k, shape, s):
        return jax.random.normal(k, shape, jnp.float32) * s

    return {
        'x': nrm(ks[0], (BATCH, SEQ, D_MODEL), 1.0),
        'norm_pre': 1.0 + nrm(ks[1], (DEPTH, D_MODEL), 0.1),
        'w_in': nrm(ks[2], (DEPTH, D_MODEL, IN_COLS), D_MODEL ** -0.5),
        'cmp_pe_k': nrm(ks[3], (DEPTH, CMP_LEN, HEAD_DIM), 0.1),
        'cmp_w1_k': nrm(ks[4], (DEPTH, CMP_LEN, HEAD_DIM, CMP_HIDDEN), (CMP_LEN * HEAD_DIM) ** -0.5),
        'cmp_w2_k': nrm(ks[5], (DEPTH, CMP_HIDDEN, HEAD_DIM), CMP_HIDDEN ** -0.5),
        'cmp_pe_v': nrm(ks[6], (DEPTH, CMP_LEN, HEAD_DIM), 0.1),
        'cmp_w1_v': nrm(ks[7], (DEPTH, CMP_LEN, HEAD_DIM, CMP_HIDDEN), (CMP_LEN * HEAD_DIM) ** -0.5),
        'cmp_w2_v': nrm(ks[8], (DEPTH, CMP_HIDDEN, HEAD_DIM), CMP_HIDDEN ** -0.5),
        'w_branch_a': nrm(ks[9], (DEPTH, NSA_WIDTH, D_MODEL), NSA_WIDTH ** -0.5),
        'w_branch_b': nrm(ks[10], (DEPTH, MOBA_WIDTH, D_MODEL), MOBA_WIDTH ** -0.5),
        'w_o': nrm(ks[11], (DEPTH, D_MODEL, D_MODEL), D_MODEL ** -0.5),
        'norm_post': 1.0 + nrm(ks[12], (DEPTH, D_MODEL), 0.1),
    }


def reference(x, norm_pre, w_in, cmp_pe_k, cmp_w1_k, cmp_w2_k, cmp_pe_v, cmp_w1_v, cmp_w2_v,
              w_branch_a, w_branch_b, w_o, norm_post):
    h = x
    for l in range(DEPTH):
        h = hybrid_layer(h, norm_pre[l], w_in[l], cmp_pe_k[l], cmp_w1_k[l], cmp_w2_k[l],
                         cmp_pe_v[l], cmp_w1_v[l], cmp_w2_v[l], w_branch_a[l], w_branch_b[l],
                         w_o[l], norm_post[l])
    return h
```

```cpp
#include <hip/hip_runtime.h>
#include <hip/hip_cooperative_groups.h>
#include <cstdio>
#include <cstdint>
namespace cg = cooperative_groups;

#ifndef MK_N_LAUNCHES
#define MK_N_LAUNCHES 1
#endif

typedef unsigned short bf16_t;
#define DEVI __device__ __forceinline__

constexpr int NB = 16, SEQ = 4096, MROWS = NB * SEQ, DM = 1024;
constexpr int INCOLS = 5912, NPROJ = 6144;
constexpr float RMS_EPS = 1e-6f;
constexpr float LOG2E = 1.4426950408889634f;
constexpr float C2 = 0.125f * LOG2E;
constexpr int NT = 512;
constexpr int NPHASE = 10;

constexpr size_t MiB = 1u << 20;
constexpr size_t WS_CTL = 0;
constexpr size_t WS_WIN = 1 * MiB;
constexpr size_t WS_WA = 13 * MiB;
constexpr size_t WS_WB = 14 * MiB;
constexpr size_t WS_WO = 15 * MiB;
constexpr size_t WS_W1K = 17 * MiB;
constexpr size_t WS_W1V = 17 * MiB + 512 * 1024;
constexpr size_t WS_W2K = 21 * MiB;
constexpr size_t WS_W2V = 21 * MiB + 64 * 1024;
constexpr size_t WS_B1P = 21 * MiB + 128 * 1024;
constexpr size_t WS_KC = 18 * MiB;
constexpr size_t WS_VC = 19 * MiB;
constexpr size_t WS_KBAR = 20 * MiB;
constexpr size_t WS_G = 26 * MiB;
constexpr size_t WS_U = 32 * MiB;
constexpr size_t WS_Y = WS_U;
constexpr size_t WS_YB = WS_U + 64 * MiB;
constexpr size_t WS_SS = 22 * MiB;
constexpr size_t WS_ATT = 160 * MiB;
constexpr size_t WS_Z = 512 * MiB;
constexpr size_t WS_MRG = 640 * MiB;
constexpr size_t WS_M1 = 160 * MiB;
constexpr size_t WS_MM = 512 * MiB;
constexpr size_t WS_END = 896 * MiB;

constexpr int HC_QA = 0, HC_KCMP = 8, HC_VCMP = 10, HC_KS = 12, HC_VS = 14, HC_KW = 16, HC_VW = 18, HC_QB = 20, HC_KB = 28, HC_VB = 36;

struct Params {
    const float *x, *norm_pre, *w_in, *pe_k, *w1_k, *w2_k, *pe_v, *w1_v, *w2_v, *w_a, *w_b, *w_o, *norm_post;
    float* out; unsigned char* ws; int ph_lo, ph_hi;
};

DEVI float bf2f(bf16_t b) { return __uint_as_float((unsigned)b << 16); }
DEVI bf16_t f2bf(float f) { unsigned u = __float_as_uint(f); return (bf16_t)((u + 0x7fffu + ((u >> 16) & 1u)) >> 16); }
DEVI float wave_max(float v) {
#pragma unroll
    for (int o = 32; o; o >>= 1) v = fmaxf(v, __shfl_xor(v, o));
    return v;
}
DEVI float wave_sum(float v) {
#pragma unroll
    for (int o = 32; o; o >>= 1) v += __shfl_xor(v, o);
    return v;
}
DEVI float sigmoidf_(float x) { return 1.f / (1.f + __expf(-x)); }
DEVI float siluf_(float x) { return x / (1.f + __expf(-x)); }
#define LDS_SYNC() asm volatile("s_waitcnt lgkmcnt(0)" ::: "memory")
DEVI int lane_id() { return (int)(__builtin_amdgcn_mbcnt_hi(~0u, __builtin_amdgcn_mbcnt_lo(~0u, 0u)) & 63u); }
DEVI int lane_id_opaque() { int l = lane_id(); asm volatile("" : "+v"(l)); return l; }

DEVI int orig_col(int n) {
    if (n < 1280) return n;
    if (n < 3840) return n + 24;
    if (n < 5888) { const int j = n - 3840, t = j >> 8, w = j & 255; return 3864 + (w < 128 ? 0 : 1024) + t * 128 + (w & 127); }
    return n - 5888 + 1280;
}
DEVI void prep_transpose_item(const float* W, int N, int src_col0, int nvalid, bf16_t* WT, int K, int dst_row0, int k0, float* scr, int lane, int dst_k_off = 0) {
    { float4 v[8]; const int c4 = (lane & 7) * 4;
#pragma unroll
      for (int i = 0; i < 8; ++i) { const int kk = 8 * i + (lane >> 3); v[i] = (c4 < nvalid) ? *(const float4*)(W + (size_t)(k0 + kk) * N + src_col0 + c4) : make_float4(0.f, 0.f, 0.f, 0.f); }
#pragma unroll
      for (int i = 0; i < 8; ++i) { const int kk = 8 * i + (lane >> 3); float* q = scr + kk * 33 + c4; q[0] = v[i].x; q[1] = v[i].y; q[2] = v[i].z; q[3] = v[i].w; } }
    LDS_SYNC();
    const int c8 = lane & 7;
#pragma unroll
    for (int j = 0; j < 4; ++j) { const int n = (lane >> 3) + 8 * j; const float* p = scr + (8 * c8) * 33 + n;
        uint4 o; o.x = (unsigned)f2bf(p[0]) | ((unsigned)f2bf(p[33]) << 16); o.y = (unsigned)f2bf(p[2 * 33]) | ((unsigned)f2bf(p[3 * 33]) << 16);
        o.z = (unsigned)f2bf(p[4 * 33]) | ((unsigned)f2bf(p[5 * 33]) << 16); o.w = (unsigned)f2bf(p[6 * 33]) | ((unsigned)f2bf(p[7 * 33]) << 16);
        *(uint4*)(WT + (size_t)(dst_row0 + n) * K + dst_k_off + k0 + 8 * c8) = o; }
    LDS_SYNC();
}
DEVI void phase_prep(const Params& P, float* lds) {
    bf16_t* WinT = (bf16_t*)(P.ws + WS_WIN); bf16_t* WaT = (bf16_t*)(P.ws + WS_WA); bf16_t* WbT = (bf16_t*)(P.ws + WS_WB); bf16_t* WoT = (bf16_t*)(P.ws + WS_WO);
    {
        const int lane = threadIdx.x & 63, wv = threadIdx.x >> 6, gw = (blockIdx.x * NT + threadIdx.x) >> 6, ngw = (gridDim.x * NT) >> 6;
        float* scr = lds + wv * 4096;
        constexpr int I_IN = 16 * 192, I_AB = 8 * 32, I_O = 16 * 32, I_W1 = 32 * 4, I_W2 = 2 * 2, I_B1 = 32;
        for (int it = gw; it < I_IN + 2 * I_AB + I_O + 2 * I_W1 + 2 * I_W2 + I_B1; it += ngw) {
            int r = it;
            if (r < I_IN) { const int kb = r / 192, nb = r % 192, n0 = nb * 32; const int nvalid = n0 + 32 <= INCOLS ? 32 : (n0 < INCOLS ? INCOLS - n0 : 0);
                prep_transpose_item(P.w_in, INCOLS, nvalid ? orig_col(n0) : 0, nvalid, WinT, DM, n0, kb * 64, scr, lane); continue; }
            r -= I_IN;
            if (r < I_AB) { prep_transpose_item(P.w_a, 1024, (r % 32) * 32, 32, WaT, 1024, (r % 32) * 32, (r / 32) * 64, scr, lane); continue; }
            r -= I_AB;
            if (r < I_AB) { prep_transpose_item(P.w_b, 1024, (r % 32) * 32, 32, WaT, 1024, (r % 32) * 32, (r / 32) * 64, scr, lane, 512); continue; }
            r -= I_AB;
            if (r < I_O) { prep_transpose_item(P.w_o, 1024, (r % 32) * 32, 32, WoT, 1024, (r % 32) * 32, (r / 32) * 64, scr, lane); continue; }
            r -= I_O;
            if (r < 2 * I_W1) { const int wh = r / I_W1, q = r % I_W1;
                prep_transpose_item(wh ? P.w1_v : P.w1_k, 128, (q % 4) * 32, 32, (bf16_t*)(P.ws + (wh ? WS_W1V : WS_W1K)), 2048, (q % 4) * 32, (q / 4) * 64, scr, lane); continue; }
            r -= 2 * I_W1;
            if (r < 2 * I_W2) { const int wh = r / I_W2, q = r % I_W2;
                prep_transpose_item(wh ? P.w2_v : P.w2_k, 64, (q % 2) * 32, 32, (bf16_t*)(P.ws + (wh ? WS_W2V : WS_W2K)), 128, (q % 2) * 32, (q / 2) * 64, scr, lane); continue; }
            r -= 2 * I_W2;
            { const int wh = r >> 4, eh = (r >> 3) & 1, ch = r & 7;
              const float* pe = wh ? P.pe_v : P.pe_k; const float* w1 = wh ? P.w1_v : P.w1_k; float acc = 0.f;
              for (int kk = ch * 256; kk < ch * 256 + 256; ++kk) acc += pe[kk] * w1[(size_t)kk * 128 + eh * 64 + lane];
              ((float*)(P.ws + WS_B1P))[(wh * 8 + ch) * 128 + eh * 64 + lane] = acc; }
        }
    }
    bf16_t* U = (bf16_t*)(P.ws + WS_U);
    const int lane = threadIdx.x & 63, gw = (blockIdx.x * NT + threadIdx.x) >> 6, ngw = (gridDim.x * NT) >> 6;
    typedef float f4_t __attribute__((ext_vector_type(4)));
    typedef float f2_t __attribute__((ext_vector_type(2)));
    typedef __bf16 b2_t __attribute__((ext_vector_type(2)));
    typedef unsigned u2_t __attribute__((ext_vector_type(2)));
    constexpr int RF = 4;
    for (int r = gw * RF; r < MROWS; r += RF * ngw) {
        f4_t a[RF][4]; float ss[RF];
#pragma unroll
        for (int q = 0; q < RF; ++q) { const f4_t* xq = (const f4_t*)(P.x + (size_t)(r + q) * DM);
#pragma unroll
            for (int j = 0; j < 4; ++j) a[q][j] = __builtin_nontemporal_load(&xq[j * 64 + lane]); }
#pragma unroll
        for (int q = 0; q < RF; ++q) { float t = 0.f;
#pragma unroll
            for (int j = 0; j < 4; ++j) t += (a[q][j][0] * a[q][j][0] + a[q][j][1] * a[q][j][1]) + (a[q][j][2] * a[q][j][2] + a[q][j][3] * a[q][j][3]);
            ss[q] = wave_sum(t); }
#pragma unroll
        for (int q = 0; q < RF; ++q) { const float rs = rsqrtf(ss[q] * (1.f / DM) + RMS_EPS);
#pragma unroll
            for (int j = 0; j < 4; ++j) { const f4_t g = ((const f4_t*)P.norm_pre)[j * 64 + lane];
                const f2_t p0 = {a[q][j][0] * rs * g[0], a[q][j][1] * rs * g[1]}, p1 = {a[q][j][2] * rs * g[2], a[q][j][3] * rs * g[3]};
                u2_t w; w.x = __builtin_bit_cast(unsigned, __builtin_convertvector(p0, b2_t)); w.y = __builtin_bit_cast(unsigned, __builtin_convertvector(p1, b2_t));
                *(u2_t*)(U + (size_t)(r + q) * DM + (j * 64 + lane) * 4) = w; } }
    }
}

namespace pg8 {
#define PG8_LAS __attribute__((address_space(3)))
typedef unsigned short bf16_t;
typedef short bf16x8 __attribute__((ext_vector_type(8)));
typedef float f32x4 __attribute__((ext_vector_type(4)));
typedef unsigned u32x4 __attribute__((ext_vector_type(4)));
constexpr int BM = 256, BK = 64, HALF = 128, HTB = HALF * BK * 2  , STAGE_BYTES = 8 * HTB, NXCD = 8, WGM = 8;

__host__ __device__ __forceinline__ int lds_byte(int r, int c) { const int st = (r >> 4) * 2 + (c >> 5), rr = r & 15, cc = c & 31, ob = rr * 64 + cc * 2; return st * 1024 + (ob ^ (((ob >> 9) & 1) << 5)); }
__host__ __device__ __forceinline__ void stage_rc(int b, int& R, int& C) { const int st = b / 1024, sb = b % 1024, swz = sb ^ (((sb >> 9) & 1) << 5); R = (st >> 1) * 16 + swz / 64; C = (st & 1) * 32 + (swz % 64) / 2; }
__host__ __device__ __forceinline__ int perm32(int rho) { const int n = rho >> 4, i = rho & 15; return 8 * (i >> 2) + 4 * n + (i & 3); }

struct Unit { int pm, pn; };
struct Gemm { const bf16_t* A; const bf16_t* Bt; int M, N, K; };

struct StaticOrder {
    int nM, nN, nwg, G, c;
    __host__ __device__ void init(int M, int N, int G_, int c_) { nM = M / BM; nN = N / BM; nwg = nM * nN; G = G_; c = c_; }
    __host__ __device__ bool next(int i, Unit& u) const {
        const long L = (long)i * G + c; if (L >= nwg) return false;
        int wgid = (int)L; { const int q = nwg / NXCD, r = nwg % NXCD, xcd = wgid % NXCD, off = wgid / NXCD; wgid = (xcd < r ? xcd * (q + 1) : r * (q + 1) + (xcd - r) * q) + off; }
        const int nig = WGM * nN, gid = wgid / nig, fm = gid * WGM, gsz = (nM - fm) < WGM ? (nM - fm) : WGM;
        u.pm = fm + ((wgid % nig) % gsz); u.pn = (wgid % nig) / gsz; return true;
    }
    __device__ __forceinline__ void a_ready(const Unit&) const {}
    __device__ __forceinline__ void done(const Unit&) const {}
};

__device__ __forceinline__ unsigned cvt_pk_bf16(float lo, float hi) { unsigned r; asm volatile("v_cvt_pk_bf16_f32 %0, %1, %2" : "=v"(r) : "v"(lo), "v"(hi)); return r; }
typedef float f32x2 __attribute__((ext_vector_type(2)));

__device__ __forceinline__ float silu_f(float x) { return x * __builtin_amdgcn_rcpf(1.f + __builtin_amdgcn_exp2f(-1.4426950408889634f * x)); }
__device__ __forceinline__ float sigm_f(float x) { return __builtin_amdgcn_rcpf(1.f + __builtin_amdgcn_exp2f(-1.4426950408889634f * x)); }
__device__ __forceinline__ float bflo(unsigned w) { return __uint_as_float(w << 16); }
__device__ __forceinline__ float bfhi(unsigned w) { return __uint_as_float(w & 0xffff0000u); }
constexpr int EM = 65536;
constexpr float EC2 = 0.125f * 1.4426950408889634f;
struct EpiProj {
    static constexpr bool PERM = true, AFTER_DRAIN = false, MIDK = false;
    bf16_t* ATT; bf16_t* Z; bf16_t* MRG; float* G;
    static constexpr int NST = 16;
    __device__ __forceinline__ bool relax(const Unit& u, int wc) const { return u.pn < 23 || wc == 0; }
    template <int KIND> __device__ __forceinline__ void tile(const f32x4 (&acc)[2][2][4][2], bf16_t* base, float sc, int row0, int cl0) const {
#pragma unroll
        for (int ai = 0; ai < 2; ++ai)
#pragma unroll
            for (int m = 0; m < 4; ++m) { const int row = row0 + ai * HALF + m * 16;
#pragma unroll
                for (int bj = 0; bj < 2; ++bj) { const int cl = cl0 + bj * HALF; f32x4 v0 = acc[ai][bj][m][0], v1 = acc[ai][bj][m][1];
                    if (KIND == 0) { v0 = v0 * sc; v1 = v1 * sc; }
                    if (KIND == 1) { for (int j = 0; j < 4; ++j) { v0[j] = silu_f(v0[j]); v1[j] = silu_f(v1[j]); } }
                    if (KIND == 2) { for (int j = 0; j < 4; ++j) { v0[j] = sigm_f(v0[j]); v1[j] = sigm_f(v1[j]); } }
                    u32x4 w; w.x = cvt_pk_bf16(v0[0], v0[1]); w.y = cvt_pk_bf16(v0[2], v0[3]); w.z = cvt_pk_bf16(v1[0], v1[1]); w.w = cvt_pk_bf16(v1[2], v1[3]);
                    bf16_t* p = (KIND == 2) ? base + (size_t)row * 2048 + cl : base + ((size_t)(cl >> 6) * EM + row) * 64 + (cl & 63);
                    *(u32x4*)p = w; } }
    }
    __device__ __forceinline__ void operator()(const f32x4 (&acc)[2][2][4][2], const Unit& u, int wr, int wc, int fr, int fq) const {
        const int pn = u.pn, row0 = u.pm * BM + wr * 64 + fr, cl0 = wc * 32 + 8 * fq; const size_t HS = (size_t)EM * 64;
        if (pn < 5) tile<0>(acc, ATT + (size_t)(pn * 4) * HS, pn < 2 ? EC2 : 1.f, row0, cl0);
        else if (pn < 7) tile<1>(acc, Z + (size_t)((pn - 5) * 4) * HS, 1.f, row0, cl0);
        else if (pn < 13) tile<0>(acc, ATT + (size_t)(20 + (pn - 7) * 4) * HS, pn < 9 ? EC2 : 1.f, row0, cl0);
        else if (pn < 15) tile<1>(acc, Z + (size_t)(8 + (pn - 13) * 4) * HS, 1.f, row0, cl0);
        else if (pn < 23) {
#pragma unroll
            for (int ai = 0; ai < 2; ++ai)
#pragma unroll
                for (int m = 0; m < 4; ++m) { const int row = row0 + ai * HALF + m * 16; const int ch = (pn - 15) * 128 + cl0;
                    f32x4 a0 = acc[ai][0][m][0], a1 = acc[ai][0][m][1], b0 = acc[ai][1][m][0], b1 = acc[ai][1][m][1];
                    for (int j = 0; j < 4; ++j) { b0[j] = sigm_f(b0[j]); b1[j] = sigm_f(b1[j]); a0[j] = sigm_f(a0[j]) * __builtin_amdgcn_rcpf(b0[j]); a1[j] = sigm_f(a1[j]) * __builtin_amdgcn_rcpf(b1[j]); }
                    u32x4 wr_, wb_; wr_.x = cvt_pk_bf16(a0[0], a0[1]); wr_.y = cvt_pk_bf16(a0[2], a0[3]); wr_.z = cvt_pk_bf16(a1[0], a1[1]); wr_.w = cvt_pk_bf16(a1[2], a1[3]);
                    wb_.x = cvt_pk_bf16(b0[0], b0[1]); wb_.y = cvt_pk_bf16(b0[2], b0[3]); wb_.z = cvt_pk_bf16(b1[0], b1[1]); wb_.w = cvt_pk_bf16(b1[2], b1[3]);
                    *(u32x4*)(MRG + (size_t)row * 2048 + ch) = wr_; *(u32x4*)(MRG + (size_t)row * 2048 + 1024 + ch) = wb_; }
        }
        else if (wc == 0 && fq < 3) {
#pragma unroll
            for (int ai = 0; ai < 2; ++ai)
#pragma unroll
                for (int m = 0; m < 4; ++m) { const int row = row0 + ai * HALF + m * 16; f32x4 v0 = acc[ai][0][m][0], v1 = acc[ai][0][m][1];
                    for (int j = 0; j < 4; ++j) { v0[j] = sigm_f(v0[j]); v1[j] = sigm_f(v1[j]); }
                    float* p = G + (size_t)row * 24 + 8 * fq; *(f32x4*)p = v0; *(f32x4*)(p + 4) = v1; }
        }
    }
};
struct EpiMG {
    static constexpr bool PERM = true, AFTER_DRAIN = false, MIDK = true;
    const bf16_t* MRG; bf16_t* MM;
    static constexpr int NST = 0;
    __device__ __forceinline__ bool relax(const Unit&, int) const { return false; }
    __device__ __forceinline__ void mid(f32x4 (&acc)[2][2][4][2], const Unit& u, int wr, int wc, int, int) const {
        const int l_ = lane_id_opaque(), fr = l_ & 15, fq = l_ >> 4;
        const int row0 = u.pm * BM + wr * 64 + fr, col0 = u.pn * BM + wc * 32 + 8 * fq;
#pragma unroll
        for (int ai = 0; ai < 2; ++ai)
#pragma unroll
            for (int m = 0; m < 4; ++m) { const int row = row0 + ai * HALF + m * 16;
#pragma unroll
                for (int bj = 0; bj < 2; ++bj) { const int col = col0 + bj * HALF; const u32x4 a = *(const u32x4*)(MRG + (size_t)row * 2048 + col);
                    f32x4& v0 = acc[ai][bj][m][0]; f32x4& v1 = acc[ai][bj][m][1];
                    v0[0] *= bflo(a.x); v0[1] *= bfhi(a.x); v0[2] *= bflo(a.y); v0[3] *= bfhi(a.y); v1[0] *= bflo(a.z); v1[1] *= bfhi(a.z); v1[2] *= bflo(a.w); v1[3] *= bfhi(a.w); }
                asm volatile("" ::: "memory"); }
    }
    __device__ __forceinline__ void operator()(const f32x4 (&acc)[2][2][4][2], const Unit& u, int wr, int wc, int fr, int fq) const {
        const int row0 = u.pm * BM + wr * 64 + fr, col0 = u.pn * BM + wc * 32 + 8 * fq;
#pragma unroll
        for (int ai = 0; ai < 2; ++ai)
#pragma unroll
            for (int m = 0; m < 4; ++m) { const int row = row0 + ai * HALF + m * 16;
#pragma unroll
                for (int bj = 0; bj < 2; ++bj) { const int col = col0 + bj * HALF; const u32x4 s = *(const u32x4*)(MRG + (size_t)row * 2048 + 1024 + col);
                    const f32x4 a0 = acc[ai][bj][m][0], a1 = acc[ai][bj][m][1];
                    u32x4 w; w.x = cvt_pk_bf16(a0[0] * bflo(s.x), a0[1] * bfhi(s.x)); w.y = cvt_pk_bf16(a0[2] * bflo(s.y), a0[3] * bfhi(s.y));
                    w.z = cvt_pk_bf16(a1[0] * bflo(s.z), a1[1] * bfhi(s.z)); w.w = cvt_pk_bf16(a1[2] * bflo(s.w), a1[3] * bfhi(s.w));
                    *(u32x4*)(MM + (size_t)row * 1024 + col) = w; } }
    }
};
struct EpiOut {
    static constexpr bool PERM = true, AFTER_DRAIN = false, MIDK = false;
    bf16_t* T; float* SS;
    static constexpr int NST = 24;
    __device__ __forceinline__ bool relax(const Unit&, int) const { return true; }
    __device__ __forceinline__ void operator()(const f32x4 (&acc)[2][2][4][2], const Unit& u, int wr, int wc, int fr, int fq) const {
        const int row0 = u.pm * BM + wr * 64 + fr, col0 = u.pn * BM + wc * 32 + 8 * fq;
#pragma unroll
        for (int ai = 0; ai < 2; ++ai)
#pragma unroll
            for (int m = 0; m < 4; ++m) { const int row = row0 + ai * HALF + m * 16; float s = 0.f;
#pragma unroll
                for (int bj = 0; bj < 2; ++bj) { const int col = col0 + bj * HALF; const f32x4 v0 = acc[ai][bj][m][0], v1 = acc[ai][bj][m][1];
                    s += (v0[0] * v0[0] + v0[1] * v0[1]) + (v0[2] * v0[2] + v0[3] * v0[3]) + (v1[0] * v1[0] + v1[1] * v1[1]) + (v1[2] * v1[2] + v1[3] * v1[3]);
                    u32x4 w; w.x = cvt_pk_bf16(v0[0], v0[1]); w.y = cvt_pk_bf16(v0[2], v0[3]); w.z = cvt_pk_bf16(v1[0], v1[1]); w.w = cvt_pk_bf16(v1[2], v1[3]);
                    *(u32x4*)(T + (size_t)row * 1024 + col) = w; }
                s += __shfl_xor(s, 16); s += __shfl_xor(s, 32);
                if (fq == 0) SS[(size_t)(u.pn * 4 + wc) * EM + row] = s; }
    }
};

template <class Epi, class Sched, bool ALIGN_EPI = false, bool SP2 = false>
__device__ __forceinline__ void gemm_phase(PG8_LAS unsigned char* lds, const Gemm g, const Sched& S, const Epi& E, const int wid) {
    const int lane = lane_id(), tid = ((wid & 7) << 6) | lane, wr = (wid >> 2) & 1, wc = wid & 3, fr = lane & 15, fq = lane >> 4;
    const int K = g.K, nt = K / BK;
    unsigned voffA[2], voffB[2];
#pragma unroll
    for (int i = 0; i < 2; ++i) { int R, C; stage_rc(tid * 16 + i * 8192, R, C); const int Rb = Epi::PERM ? ((R & ~31) + perm32(R & 31)) : R;
        voffA[i] = (unsigned)(R * K + C) * 2u; voffB[i] = (unsigned)(Rb * K + C) * 2u; }
    const size_t kstep = (size_t)(BK * 2);
    const size_t hstep = (size_t)HALF * K * 2;
    const size_t tstep = 2 * hstep;
    const unsigned ldsw = (unsigned)wid * 1024u;
    const int aoff = lds_byte(wr * 64 + fr, fq * 8), boff = lds_byte(wc * 32 + fr, fq * 8);
#define PG8_SA(b, h) (((b) * 2 + (h)) * HTB)
#define PG8_SB(b, h) ((4 + (b) * 2 + (h)) * HTB)
#define PG8_STAGE(bufoff, gbase, voff) do { _Pragma("unroll") for (int _i = 0; _i < 2; ++_i) \
        __builtin_amdgcn_global_load_lds((const unsigned*)((const char*)(gbase) + (voff)[_i]), (PG8_LAS unsigned*)(lds + (bufoff) + ldsw + _i * 8192), 16, 0, 0); } while (0)
#define PG8_LDA(dst, b, h) do { _Pragma("unroll") for (int m = 0; m < 4; ++m) _Pragma("unroll") for (int k = 0; k < 2; ++k) dst[m][k] = *(const PG8_LAS bf16x8*)(lds + PG8_SA(b, h) + aoff + m * 2048 + k * 1024); } while (0)
#define PG8_LDB(dst, b, h) do { _Pragma("unroll") for (int n = 0; n < 2; ++n) _Pragma("unroll") for (int k = 0; k < 2; ++k) dst[n][k] = *(const PG8_LAS bf16x8*)(lds + PG8_SB(b, h) + boff + n * 2048 + k * 1024); } while (0)
#define PG8_MMA(ai, bj, At, Bt) do { __builtin_amdgcn_s_setprio(1); _Pragma("unroll") for (int m = 0; m < 4; ++m) _Pragma("unroll") for (int n = 0; n < 2; ++n) _Pragma("unroll") for (int k = 0; k < 2; ++k) \
        acc[ai][bj][m][n] = __builtin_amdgcn_mfma_f32_16x16x32_bf16(Bt[n][k], At[m][k], acc[ai][bj][m][n], 0, 0, 0); __builtin_amdgcn_s_setprio(0); } while (0)
#define PG8_WAIT_V(n) asm volatile("s_waitcnt vmcnt(" #n ")" ::: "memory")
#define PG8_WAIT_L(n) asm volatile("s_waitcnt lgkmcnt(" #n ")" ::: "memory")
#define PG8_BAR __builtin_amdgcn_s_barrier()
#define PG8_SCHED __builtin_amdgcn_sched_barrier(0)
#define PG8_KT2(WV3, A11) do { \
            PG8_LDB(B0, 0, 0); PG8_LDB(B1, 0, 1); PG8_SCHED; PG8_LDA(At, 0, 0); if (A11) PG8_STAGE(PG8_SA(1, 1), a1 + hstep, voffA); \
            WV3; PG8_WAIT_L(0); PG8_BAR; PG8_MMA(0, 0, At, B0); PG8_MMA(0, 1, At, B1); PG8_BAR; PG8_SCHED; \
            PG8_LDA(At, 0, 1); PG8_STAGE(PG8_SB(0, 0), b2, voffB); PG8_STAGE(PG8_SB(0, 1), b2 + hstep, voffB); PG8_STAGE(PG8_SA(0, 0), a2, voffA); \
            WV3; PG8_WAIT_L(0); PG8_BAR; PG8_MMA(1, 0, At, B0); PG8_MMA(1, 1, At, B1); PG8_BAR; PG8_SCHED; \
            PG8_LDB(B0, 1, 0); PG8_LDB(B1, 1, 1); PG8_SCHED; PG8_LDA(At, 1, 0); PG8_STAGE(PG8_SA(0, 1), a2 + hstep, voffA); \
            WV3; PG8_WAIT_L(0); PG8_BAR; PG8_MMA(0, 0, At, B0); PG8_MMA(0, 1, At, B1); PG8_BAR; PG8_SCHED; \
            PG8_LDA(At, 1, 1); PG8_STAGE(PG8_SB(1, 0), b3, voffB); PG8_STAGE(PG8_SB(1, 1), b3 + hstep, voffB); PG8_STAGE(PG8_SA(1, 0), a3, voffA); \
            PG8_WAIT_V(8); PG8_WAIT_L(0); PG8_BAR; PG8_MMA(1, 0, At, B0); PG8_MMA(1, 1, At, B1); PG8_BAR; PG8_SCHED; } while (0)
    Unit cur, nxt; int ui = 0; bool rx = false;
    if (!S.next(0, cur)) return;
    f32x4 acc[2][2][4][2];
#pragma unroll
    for (int a = 0; a < 2; ++a)
#pragma unroll
        for (int b = 0; b < 2; ++b)
#pragma unroll
            for (int m = 0; m < 4; ++m)
#pragma unroll
                for (int n = 0; n < 2; ++n) { acc[a][b][m][n] = (f32x4){0.f, 0.f, 0.f, 0.f}; asm volatile("" : "+v"(acc[a][b][m][n])); }
    bf16x8 At[4][2], B0[2][2], B1[2][2];
    const char* cA = (const char*)g.A + (size_t)cur.pm * tstep; const char* cB = (const char*)g.Bt + (size_t)cur.pn * tstep;
    S.a_ready(cur);
    if constexpr (SP2) {
        PG8_STAGE(PG8_SB(0, 0), cB, voffB); PG8_STAGE(PG8_SB(0, 1), cB + hstep, voffB); PG8_STAGE(PG8_SA(0, 0), cA, voffA); PG8_STAGE(PG8_SA(0, 1), cA + hstep, voffA);
        if (wr == 1) PG8_BAR;
        PG8_WAIT_V(2); PG8_BAR;
        PG8_STAGE(PG8_SB(1, 0), cB + kstep, voffB); PG8_STAGE(PG8_SA(1, 0), cA + kstep, voffA); PG8_STAGE(PG8_SB(1, 1), cB + hstep + kstep, voffB);
        PG8_WAIT_V(6); PG8_BAR;
    } else {
        PG8_STAGE(PG8_SB(0, 0), cB, voffB); PG8_STAGE(PG8_SA(0, 0), cA, voffA); PG8_STAGE(PG8_SB(0, 1), cB + hstep, voffB); PG8_STAGE(PG8_SA(0, 1), cA + hstep, voffA);
        if (wr == 1) PG8_BAR;
        PG8_WAIT_V(4); PG8_BAR;
        PG8_STAGE(PG8_SB(1, 0), cB + kstep, voffB); PG8_STAGE(PG8_SA(1, 0), cA + kstep, voffA); PG8_STAGE(PG8_SB(1, 1), cB + hstep + kstep, voffB);
        PG8_WAIT_V(6); PG8_BAR;
    }
    for (;;) {
        const bool has_next = S.next(ui + 1, nxt);
        const char* nA = has_next ? (const char*)g.A + (size_t)nxt.pm * tstep : cA; const char* nB = has_next ? (const char*)g.Bt + (size_t)nxt.pn * tstep : cB;
        int t0 = 0;
        if constexpr (SP2 && Epi::NST > 0) { if (rx) {
            const char* a1 = cA + kstep; const char* a2 = cA + 2 * kstep; const char* b2 = cB + 2 * kstep; const char* a3 = a2 + kstep; const char* b3 = b2 + kstep;
            if constexpr (Epi::NST == 16) PG8_KT2(PG8_WAIT_V(24), false); else PG8_KT2(PG8_WAIT_V(32), false);
            t0 = 2; rx = false; } }
        for (int t = t0; t < nt; t += 2) {
            if constexpr (Epi::MIDK) { if (t == nt / 2) { __builtin_amdgcn_sched_barrier(0); E.mid(acc, cur, wr, wc, fr, fq); __builtin_amdgcn_sched_barrier(0); } }
            const bool last = (t == nt - 2);
            const char* a1 = cA + (size_t)(t + 1) * kstep;
            const char* a2 = last ? nA : cA + (size_t)(t + 2) * kstep; const char* b2 = last ? nB : cB + (size_t)(t + 2) * kstep;
            const char* a3 = a2 + kstep; const char* b3 = b2 + kstep;
            if (last && has_next) S.a_ready(nxt);
            if constexpr (SP2) {
            PG8_KT2(PG8_WAIT_V(8), true);
            } else {
            PG8_LDB(B0, 0, 0); PG8_SCHED; PG8_LDA(At, 0, 0); PG8_STAGE(PG8_SA(1, 1), a1 + hstep, voffA);
            PG8_WAIT_L(8); PG8_BAR; PG8_WAIT_L(0); PG8_MMA(0, 0, At, B0); PG8_BAR; PG8_SCHED;
            PG8_LDB(B1, 0, 1); PG8_STAGE(PG8_SB(0, 0), b2, voffB);
            PG8_BAR; PG8_WAIT_L(0); PG8_MMA(0, 1, At, B1); PG8_BAR;
            PG8_LDA(At, 0, 1); PG8_STAGE(PG8_SA(0, 0), a2, voffA);
            PG8_BAR; PG8_WAIT_L(0); PG8_MMA(1, 0, At, B0); PG8_BAR; PG8_SCHED;
            PG8_STAGE(PG8_SB(0, 1), b2 + hstep, voffB);
            PG8_WAIT_V(6); PG8_BAR; PG8_MMA(1, 1, At, B1); PG8_BAR;
            PG8_LDB(B0, 1, 0); PG8_SCHED; PG8_LDA(At, 1, 0); PG8_STAGE(PG8_SA(0, 1), a2 + hstep, voffA);
            PG8_WAIT_L(8); PG8_BAR; PG8_WAIT_L(0); PG8_MMA(0, 0, At, B0); PG8_BAR; PG8_SCHED;
            PG8_LDB(B1, 1, 1); PG8_STAGE(PG8_SB(1, 0), b3, voffB);
            PG8_BAR; PG8_WAIT_L(0); PG8_MMA(0, 1, At, B1); PG8_BAR;
            PG8_LDA(At, 1, 1); PG8_STAGE(PG8_SA(1, 0), a3, voffA);
            PG8_BAR; PG8_WAIT_L(0); PG8_MMA(1, 0, At, B0); PG8_BAR; PG8_SCHED;
            PG8_STAGE(PG8_SB(1, 1), b3 + hstep, voffB);
            PG8_WAIT_V(6); PG8_BAR; PG8_MMA(1, 1, At, B1); PG8_BAR;
            }
        }
        if constexpr (ALIGN_EPI) { if (wr == 0) PG8_BAR; }
        if constexpr (SP2 && !Epi::AFTER_DRAIN) { if constexpr (Epi::NST > 0) { if (has_next && E.relax(cur, wc)) { PG8_STAGE(PG8_SA(1, 1), nA + kstep + hstep, voffA); rx = true; } } }
        if constexpr (!Epi::AFTER_DRAIN) { E(acc, cur, wr, wc, fr, fq); S.done(cur); }
        if (!has_next) break;
#pragma unroll
        for (int a = 0; a < 2; ++a)
#pragma unroll
            for (int b = 0; b < 2; ++b)
#pragma unroll
                for (int m = 0; m < 4; ++m)
#pragma unroll
                    for (int n = 0; n < 2; ++n) { acc[a][b][m][n] = (f32x4){0.f, 0.f, 0.f, 0.f}; asm volatile("" : "+v"(acc[a][b][m][n])); }
        cur = nxt; cA = nA; cB = nB; ++ui;
        if constexpr (ALIGN_EPI) { if (wr == 1) PG8_BAR; }
    }
    PG8_WAIT_V(0);
    if constexpr (!ALIGN_EPI) { if (wr == 0) PG8_BAR; }
    PG8_BAR;
    if constexpr (Epi::AFTER_DRAIN) { E.fused(acc, cur, wr, wc, fr, fq, lds, wid, lane); S.done(cur); }
#undef PG8_SA
#undef PG8_SB
#undef PG8_STAGE
#undef PG8_LDA
#undef PG8_LDB
#undef PG8_MMA
#undef PG8_KT2
#undef PG8_WAIT_V
#undef PG8_WAIT_L
#undef PG8_BAR
#undef PG8_SCHED
}
}

DEVI void phase_compress(const Params& P, float* lds, const int wid) {
    const bf16_t* ATT = (const bf16_t*)(P.ws + WS_ATT);
    const int lane = lane_id_opaque(), wv = wid, gw = blockIdx.x * (NT / 64) + wid, ngw = (gridDim.x * NT) >> 6;
    float* hl = lds + wv * 128;
    for (int it = gw; it < 2 * NB * 2 * 256; it += ngw) {
        const int n = it & 255, g = (it >> 8) & 1, b = (it >> 9) & 15, which = it >> 13;
        bf16_t* OUT = (bf16_t*)(P.ws + (which ? WS_VC : WS_KC)) + ((size_t)((b * 2 + g) * 256 + n)) * 64;
        if (n == 255) { OUT[lane] = 0; continue; }
        const float* pe = which ? P.pe_v : P.pe_k; const float* w1 = which ? P.w1_v : P.w1_k; const float* w2 = which ? P.w2_v : P.w2_k;
        const bf16_t* src = ATT + ((size_t)((which ? HC_VCMP : HC_KCMP) + g) * MROWS + (size_t)b * SEQ + n * 16) * 64;
        float h0 = 0.f, h1 = 0.f;
        for (int kk = 0; kk < 2048; ++kk) { const float a = bf2f(src[kk]) + pe[kk]; h0 += a * w1[(size_t)kk * 128 + lane]; h1 += a * w1[(size_t)kk * 128 + 64 + lane]; }
        hl[lane] = siluf_(h0); hl[64 + lane] = siluf_(h1); LDS_SYNC();
        float o = 0.f;
        for (int e = 0; e < 128; ++e) o += hl[e] * w2[e * 64 + lane];
        OUT[lane] = f2bf(o); LDS_SYNC();
    }
    float* KBAR = (float*)(P.ws + WS_KBAR);
    for (int it = gw; it < NB * 8 * 16; it += ngw) {
        const int n = it & 15, h = (it >> 4) & 7, b = it >> 7;
        const bf16_t* src = ATT + ((size_t)(HC_KB + h) * MROWS + (size_t)b * SEQ + n * 256) * 64;
        float s = 0.f;
        for (int r = 0; r < 256; ++r) s += bf2f(src[r * 64 + lane]);
        KBAR[(size_t)it * 64 + lane] = s * (1.f / 256.f);
    }
}

#define NAIVE_NSA 0
#ifndef PROBE_NSA2
#define PROBE_NSA2 0
#endif
#ifndef PROBE_MOBA2
#define PROBE_MOBA2 0
#endif
#define NAIVE_MOBA 0
namespace att {
#define ALAS __attribute__((address_space(3)))
typedef short bf16x8 __attribute__((ext_vector_type(8)));
typedef short s16x4 __attribute__((ext_vector_type(4)));
typedef short v4i16_t __attribute__((ext_vector_type(4)));
typedef float f32x16 __attribute__((ext_vector_type(16)));
typedef float f32x4 __attribute__((ext_vector_type(4)));
typedef unsigned u32x4 __attribute__((ext_vector_type(4)));
typedef unsigned u32x2 __attribute__((ext_vector_type(2)));
typedef float f32x2_t __attribute__((ext_vector_type(2)));
typedef __bf16 bf16x2_t __attribute__((ext_vector_type(2)));
typedef ALAS char lchar;

constexpr float NEG = -1e30f, MFLOOR = -8192.f, THR = 6.f;
constexpr int BIG = 1000000;
constexpr int WAVE_BYTES = 11264;
constexpr int L_K = 0, L_V = 24576, L_OVT = 49152, L_KBT = 65536, L_TL = L_KBT, L_WAVE = 73728, L_WG = L_WAVE + 2688;
constexpr int W_WSF = 0, W_IMP = 512, W_MASK = 2560, W_OT = 3072;
static_assert(L_WAVE + 8 * WAVE_BYTES <= 163840, "attention LDS map");

#define ATT_MFMA(a, b, c) __builtin_amdgcn_mfma_f32_32x32x16_bf16(a, b, c, 0, 0, 0)
#define ATT_LSYNC() asm volatile("s_waitcnt lgkmcnt(0)" ::: "memory")
#define ATT_BAR() do { asm volatile("s_waitcnt lgkmcnt(0)" ::: "memory"); __builtin_amdgcn_s_barrier(); asm volatile("" ::: "memory"); } while (0)

DEVI int crow(int r, int hi) { return (r & 3) + 8 * (r >> 2) + 4 * hi; }
DEVI float max3f(float a, float b, float c) { float r; asm("v_max3_f32 %0, %1, %2, %3" : "=v"(r) : "v"(a), "v"(b), "v"(c)); return r; }
DEVI float max2f(float a, float b) { float r; asm("v_max_f32_e32 %0, %1, %2" : "=v"(r) : "v"(a), "v"(b)); return r; }
DEVI unsigned cvtpk(float lo, float hi) { f32x2_t v = {lo, hi}; bf16x2_t b = __builtin_convertvector(v, bf16x2_t); return __builtin_bit_cast(unsigned, b); }
DEVI s16x4 vtr(const lchar* p) { return __builtin_bit_cast(s16x4, __builtin_amdgcn_ds_read_tr16_b64_v4i16((ALAS v4i16_t*)p)); }
DEVI float swap_other(float x, int hi) { auto rr = __builtin_amdgcn_permlane32_swap(__float_as_uint(x), __float_as_uint(x), false, false); return __uint_as_float(hi ? rr[0] : rr[1]); }
DEVI float swap_max(float x) { auto rr = __builtin_amdgcn_permlane32_swap(__float_as_uint(x), __float_as_uint(x), false, false); return fmaxf(__uint_as_float(rr[0]), __uint_as_float(rr[1])); }
DEVI float swap_sum(float x) { auto rr = __builtin_amdgcn_permlane32_swap(__float_as_uint(x), __float_as_uint(x), false, false); return __uint_as_float(rr[0]) + __uint_as_float(rr[1]); }

struct Stage { u32x4 k, v; };
DEVI void stage_load(Stage& s, const bf16_t* Kblk, const bf16_t* Vblk, int wid, int lane) {
    s.k = *(const u32x4*)(Kblk + lane * 64 + wid * 8);
    s.v = *(const u32x4*)(Vblk + (16 * (wid & 3) + (lane >> 2)) * 64 + (wid >> 2) * 32 + (lane & 3) * 8);
}
DEVI void stage_write(const Stage& s, lchar* Kb, lchar* Vb, int wid, int lane) {
    *(ALAS u32x4*)(Kb + wid * 1024 + lane * 16) = s.k;
    *(ALAS u32x4*)(Vb + wid * 1024 + lane * 16) = s.v;
}

template <int NO, bool EMASK>
DEVI void flash_block(const lchar* Kb, const lchar* Vb, const lchar* OVb, const bf16x8 (&qr)[4], f32x16 (&o)[NO], float& m, float& l, const bool first,
                      const float cbase, const float kslope, const int lim_lo, const int lim_hi, ALAS float* wsf, const int lane) {
    const int r32 = lane & 31, hi = lane >> 5;
    const float cb = first ? cbase : cbase - m;
    f32x16 p0, p1;
#pragma unroll
    for (int r = 0; r < 16; ++r) { const float lit = (float)((r & 3) + 8 * (r >> 2)); p0[r] = __builtin_fmaf(kslope, lit, cb); p1[r] = __builtin_fmaf(kslope, lit + 32.f, cb); }
    const lchar* kb = Kb + hi * 1024 + r32 * 16;
    __builtin_amdgcn_s_setprio(1);
#pragma unroll
    for (int d0 = 0; d0 < 4; ++d0) {
        const bf16x8 b0 = *(const ALAS bf16x8*)(kb + d0 * 2048), b1 = *(const ALAS bf16x8*)(kb + d0 * 2048 + 512);
        p0 = ATT_MFMA(b0, qr[d0], p0); p1 = ATT_MFMA(b1, qr[d0], p1);
        if (NO > 2 && (d0 & 1)) __builtin_amdgcn_sched_barrier(0);
    }
    __builtin_amdgcn_s_setprio(0);
    const int va = ((lane >> 4) & 1) * 32 + (lane & 3) * 8 + (4 * hi + ((lane & 15) >> 2)) * 64;
    bf16x8 vfr[1][4];
    if (NO == 2) {
#pragma unroll
        for (int d = 0; d < 1; ++d) {
            const lchar* vb = Vb + d * 4096 + va;
#pragma unroll
            for (int ks = 0; ks < 4; ++ks) { const s16x4 lo4 = vtr(vb + ks * 1024), hi4 = vtr(vb + ks * 1024 + 512);
                vfr[d][ks] = (bf16x8){lo4[0], lo4[1], lo4[2], lo4[3], hi4[0], hi4[1], hi4[2], hi4[3]}; }
        }
        __builtin_amdgcn_sched_barrier(0);
    }
    if (EMASK) {
        const int lo_ = lim_lo - 4 * hi, hi_ = lim_hi - 4 * hi;
#pragma unroll
        for (int r = 0; r < 16; ++r) { const int lit = (r & 3) + 8 * (r >> 2);
            p0[r] = (lit >= lo_ && lit <= hi_) ? p0[r] : NEG; p1[r] = (lit + 32 >= lo_ && lit + 32 <= hi_) ? p1[r] : NEG; }
    }
    float rm, rm2;
    { rm = max3f(p0[0], p0[1], p1[0]); rm2 = max3f(p0[2], p0[3], p1[1]); rm = max3f(rm, p1[2], p1[3]);
#pragma unroll
      for (int r = 4; r < 16; r += 4) { rm = max3f(rm, p0[r], p0[r + 1]); rm2 = max3f(rm2, p0[r + 2], p0[r + 3]); rm = max3f(rm, p1[r], p1[r + 1]); rm2 = max3f(rm2, p1[r + 2], p1[r + 3]); }
      rm = max2f(rm, rm2); }
    { auto rr = __builtin_amdgcn_permlane32_swap(__float_as_uint(rm), __float_as_uint(rm), false, false); rm = max2f(__uint_as_float(rr[0]), __uint_as_float(rr[1])); }
    float dl = 0.f; bool sub;
    if (first) { m = max2f(rm, MFLOOR); dl = m; sub = true; }
    else {
        sub = __any(rm > THR);
        if (sub) {
            dl = max2f(rm, 0.f); m += dl;
            const float alpha = __builtin_amdgcn_exp2f(-dl); l *= alpha;
            wsf[r32] = alpha; ATT_LSYNC();
#pragma unroll
            for (int r = 0; r < 16; ++r) { const float a = wsf[crow(r, hi)];
#pragma unroll
                for (int d = 0; d < NO; ++d) o[d][r] *= a; }
            ATT_LSYNC();
        }
    }
    if (sub) {
#pragma unroll
        for (int r = 0; r < 16; ++r) { p0[r] -= dl; p1[r] -= dl; }
    }
    float s = 0.f;
#pragma unroll
    for (int r = 0; r < 16; ++r) { p0[r] = __builtin_amdgcn_exp2f(p0[r]); p1[r] = __builtin_amdgcn_exp2f(p1[r]); s += p0[r] + p1[r]; }
    l += s;
    u32x4 pw[4];
    pw[0] = (u32x4){cvtpk(p0[0], p0[1]), cvtpk(p0[2], p0[3]), cvtpk(p0[4], p0[5]), cvtpk(p0[6], p0[7])};
    pw[1] = (u32x4){cvtpk(p0[8], p0[9]), cvtpk(p0[10], p0[11]), cvtpk(p0[12], p0[13]), cvtpk(p0[14], p0[15])};
    pw[2] = (u32x4){cvtpk(p1[0], p1[1]), cvtpk(p1[2], p1[3]), cvtpk(p1[4], p1[5]), cvtpk(p1[6], p1[7])};
    pw[3] = (u32x4){cvtpk(p1[8], p1[9]), cvtpk(p1[10], p1[11]), cvtpk(p1[12], p1[13]), cvtpk(p1[14], p1[15])};
    if (NO == 2) {
        bf16x8 vf1[4];
#pragma unroll
        for (int ks = 0; ks < 4; ++ks) { const lchar* vb = Vb + 4096 + va; const s16x4 lo4 = vtr(vb + ks * 1024), hi4 = vtr(vb + ks * 1024 + 512);
            vf1[ks] = (bf16x8){lo4[0], lo4[1], lo4[2], lo4[3], hi4[0], hi4[1], hi4[2], hi4[3]}; }
        __builtin_amdgcn_s_setprio(1);
#pragma unroll
        for (int ks = 0; ks < 4; ++ks) o[0] = ATT_MFMA(__builtin_bit_cast(bf16x8, pw[ks]), vfr[0][ks], o[0]);
#pragma unroll
        for (int ks = 0; ks < 4; ++ks) o[1] = ATT_MFMA(__builtin_bit_cast(bf16x8, pw[ks]), vf1[ks], o[1]);
        __builtin_amdgcn_s_setprio(0);
    } else {
#pragma unroll
        for (int d = 0; d < NO; ++d) {
            const lchar* vb = (d < 2 ? Vb + d * 4096 : OVb + (d - 2) * 4096) + va;
#pragma unroll
            for (int ks = 0; ks < 4; ++ks) {
                const s16x4 lo4 = vtr(vb + ks * 1024), hi4 = vtr(vb + ks * 1024 + 512);
                const bf16x8 vf = {lo4[0], lo4[1], lo4[2], lo4[3], hi4[0], hi4[1], hi4[2], hi4[3]};
                o[d] = ATT_MFMA(__builtin_bit_cast(bf16x8, pw[ks]), vf, o[d]);
            }
            __builtin_amdgcn_sched_barrier(0);
        }
    }
}


DEVI void glds16s(const void* sbase, unsigned voff, unsigned lds_dst) { unsigned keep;
    asm volatile("s_mov_b32 %0, m0\n\ts_mov_b32 m0, %3\n\ts_nop 0\n\tglobal_load_lds_dwordx4 %1, %2\n\ts_mov_b32 m0, %0" : "=&s"(keep) : "v"(voff), "s"(sbase), "s"(lds_dst) : "memory"); }
DEVI void glds16(const void* gsrc, unsigned lds_dst) { unsigned keep;
    asm volatile("s_mov_b32 %0, m0\n\ts_mov_b32 m0, %2\n\ts_nop 0\n\tglobal_load_lds_dwordx4 %1, off\n\ts_mov_b32 m0, %0" : "=&s"(keep) : "v"(gsrc), "s"(lds_dst) : "memory"); }
#define ATT_WAIT_BAR(N) asm volatile("s_waitcnt vmcnt(" #N ") lgkmcnt(0)\n\ts_barrier" ::: "memory")
#define ATT_WAIT_BAR_N(n) do { if ((n) >= 3) ATT_WAIT_BAR(3); else if ((n) == 2) ATT_WAIT_BAR(2); else if ((n) == 1) ATT_WAIT_BAR(1); else ATT_WAIT_BAR(0); } while (0)
DEVI void kload8(bf16x8 (&kf)[8], const lchar* kp) {
#pragma unroll
    for (int d0 = 0; d0 < 4; ++d0) { kf[2 * d0] = *(const ALAS bf16x8*)(kp + d0 * 2048); kf[2 * d0 + 1] = *(const ALAS bf16x8*)(kp + d0 * 2048 + 512); }
}
template <bool EMASK>
DEVI void qk_softmax(const bf16x8 (&kf)[8], const bf16x8 (&qr)[4], f32x16 (&o)[2], float& m, float& l, const bool first,
                     const float cbase, const float kslope, const int lim_lo, const int lim_hi, ALAS float* wsf, const int lane, u32x4 (&pw)[4]) {
    const int r32 = lane & 31, hi = lane >> 5;
    const float cb = first ? cbase : cbase - m;
    f32x16 p0, p1;
#pragma unroll
    for (int r = 0; r < 16; ++r) { const float lit = (float)((r & 3) + 8 * (r >> 2)); p0[r] = __builtin_fmaf(kslope, lit, cb); p1[r] = __builtin_fmaf(kslope, lit + 32.f, cb); }
    __builtin_amdgcn_s_setprio(1);
#pragma unroll
    for (int d0 = 0; d0 < 4; ++d0) { p0 = ATT_MFMA(kf[2 * d0], qr[d0], p0); p1 = ATT_MFMA(kf[2 * d0 + 1], qr[d0], p1); }
    __builtin_amdgcn_s_setprio(0);
    if (EMASK) {
        const int lo_ = lim_lo - 4 * hi, hi_ = lim_hi - 4 * hi;
#pragma unroll
        for (int r = 0; r < 16; ++r) { const int lit = (r & 3) + 8 * (r >> 2);
            p0[r] = (lit >= lo_ && lit <= hi_) ? p0[r] : NEG; p1[r] = (lit + 32 >= lo_ && lit + 32 <= hi_) ? p1[r] : NEG; }
    }
    float rm, rm2;
    { rm = max3f(p0[0], p0[1], p1[0]); rm2 = max3f(p0[2], p0[3], p1[1]); rm = max3f(rm, p1[2], p1[3]);
#pragma unroll
      for (int r = 4; r < 16; r += 4) { rm = max3f(rm, p0[r], p0[r + 1]); rm2 = max3f(rm2, p0[r + 2], p0[r + 3]); rm = max3f(rm, p1[r], p1[r + 1]); rm2 = max3f(rm2, p1[r + 2], p1[r + 3]); }
      rm = max2f(rm, rm2); }
    { auto rr = __builtin_amdgcn_permlane32_swap(__float_as_uint(rm), __float_as_uint(rm), false, false); rm = max2f(__uint_as_float(rr[0]), __uint_as_float(rr[1])); }
    float dl = 0.f; bool sub;
    if (first) { m = max2f(rm, MFLOOR); dl = m; sub = true; }
    else {
        sub = __any(rm > THR);
        if (sub) {
            dl = max2f(rm, 0.f); m += dl;
            const float alpha = __builtin_amdgcn_exp2f(-dl); l *= alpha;
            wsf[r32] = alpha; ATT_LSYNC();
#pragma unroll
            for (int r = 0; r < 16; ++r) { const float a = wsf[crow(r, hi)]; o[0][r] *= a; o[1][r] *= a; }
            ATT_LSYNC();
        }
    }
    if (sub) {
#pragma unroll
        for (int r = 0; r < 16; ++r) { p0[r] -= dl; p1[r] -= dl; }
    }
    float s = 0.f;
#pragma unroll
    for (int r = 0; r < 16; ++r) { p0[r] = __builtin_amdgcn_exp2f(p0[r]); p1[r] = __builtin_amdgcn_exp2f(p1[r]); s += p0[r] + p1[r]; }
    l += s;
    pw[0] = (u32x4){cvtpk(p0[0], p0[1]), cvtpk(p0[2], p0[3]), cvtpk(p0[4], p0[5]), cvtpk(p0[6], p0[7])};
    pw[1] = (u32x4){cvtpk(p0[8], p0[9]), cvtpk(p0[10], p0[11]), cvtpk(p0[12], p0[13]), cvtpk(p0[14], p0[15])};
    pw[2] = (u32x4){cvtpk(p1[0], p1[1]), cvtpk(p1[2], p1[3]), cvtpk(p1[4], p1[5]), cvtpk(p1[6], p1[7])};
    pw[3] = (u32x4){cvtpk(p1[8], p1[9]), cvtpk(p1[10], p1[11]), cvtpk(p1[12], p1[13]), cvtpk(p1[14], p1[15])};
}
DEVI void pv2(const u32x4 (&pw)[4], const lchar* Vb, f32x16 (&o)[2], const int lane) {
    const int hi = lane >> 5;
    const int va = ((lane >> 4) & 1) * 32 + (lane & 3) * 8 + (4 * hi + ((lane & 15) >> 2)) * 64;
    bf16x8 vf[2][4];
#pragma unroll
    for (int d = 0; d < 2; ++d) { const lchar* vb = Vb + d * 4096 + va;
#pragma unroll
        for (int ks = 0; ks < 4; ++ks) { const s16x4 lo4 = vtr(vb + ks * 1024), hi4 = vtr(vb + ks * 1024 + 512);
            vf[d][ks] = (bf16x8){lo4[0], lo4[1], lo4[2], lo4[3], hi4[0], hi4[1], hi4[2], hi4[3]}; } }
    __builtin_amdgcn_s_setprio(1);
#pragma unroll
    for (int d = 0; d < 2; ++d)
#pragma unroll
        for (int ks = 0; ks < 4; ++ks) o[d] = ATT_MFMA(__builtin_bit_cast(bf16x8, pw[ks]), vf[d][ks], o[d]);
    __builtin_amdgcn_s_setprio(0);
}


#define SBAR() __builtin_amdgcn_sched_barrier(0)
#define PIN(x) asm volatile("" : "+v"(x))
#define fmak(a, K, c) ([&]() { float r_; asm("v_fmamk_f32 %0, %1, %3, %2" : "=v"(r_) : "v"(a), "v"(c), "n"(__builtin_bit_cast(unsigned, (float)(K)))); return r_; }())
DEVI unsigned cvtpk_a(float lo, float hi) { unsigned r; asm("v_cvt_pk_bf16_f32 %0, %1, %2" : "=v"(r) : "v"(lo), "v"(hi)); return r; }
DEVI void kload2(bf16x8 (&kf)[8], const lchar* kp, int d0) { kf[2 * d0] = *(const ALAS bf16x8*)(kp + d0 * 2048); kf[2 * d0 + 1] = *(const ALAS bf16x8*)(kp + d0 * 2048 + 512); }
DEVI float rowmax32(const f32x16& p0, const f32x16& p1) {
    float rm, rm2;
    asm("v_max3_f32 %0, %1, %2, %3\n\tv_max3_f32 %0, %0, %4, %5\n\tv_max3_f32 %0, %0, %6, %7\n\tv_max3_f32 %0, %0, %8, %9\n\tv_max3_f32 %0, %0, %10, %11\n\tv_max3_f32 %0, %0, %12, %13\n\tv_max3_f32 %0, %0, %14, %15\n\tv_max3_f32 %0, %0, %16, %17"
        : "=&v"(rm) : "v"(p0[0]), "v"(p0[1]), "v"(p1[0]), "v"(p1[2]), "v"(p1[3]), "v"(p0[4]), "v"(p0[5]), "v"(p1[4]), "v"(p1[5]), "v"(p0[8]), "v"(p0[9]), "v"(p1[8]), "v"(p1[9]), "v"(p0[12]), "v"(p0[13]), "v"(p1[12]), "v"(p1[13]));
    asm("v_max3_f32 %0, %1, %2, %3\n\tv_max3_f32 %0, %0, %4, %5\n\tv_max3_f32 %0, %0, %6, %7\n\tv_max3_f32 %0, %0, %8, %9\n\tv_max3_f32 %0, %0, %10, %11\n\tv_max3_f32 %0, %0, %12, %13\n\tv_max3_f32 %0, %0, %14, %15"
        : "=&v"(rm2) : "v"(p0[2]), "v"(p0[3]), "v"(p1[1]), "v"(p0[6]), "v"(p0[7]), "v"(p1[6]), "v"(p1[7]), "v"(p0[10]), "v"(p0[11]), "v"(p1[10]), "v"(p1[11]), "v"(p0[14]), "v"(p0[15]), "v"(p1[14]), "v"(p1[15]));
    rm = max2f(rm, rm2);
    auto rr = __builtin_amdgcn_permlane32_swap(__float_as_uint(rm), __float_as_uint(rm), false, false); return max2f(__uint_as_float(rr[0]), __uint_as_float(rr[1])); }
DEVI void emask_apply(f32x16& p0, f32x16& p1, const int lim_lo, const int lim_hi, const int hi) {
    const int lo_ = lim_lo - 4 * hi, hi_ = lim_hi - 4 * hi;
#pragma unroll
    for (int r = 0; r < 16; ++r) { const int lit = (r & 3) + 8 * (r >> 2);
        p0[r] = (lit >= lo_ && lit <= hi_) ? p0[r] : NEG; p1[r] = (lit + 32 >= lo_ && lit + 32 <= hi_) ? p1[r] : NEG; } }
template <class Seq>
DEVI void pipe_pass(lchar* L, const Seq& seq, const bf16_t* Kb, const bf16_t* Vb, const bf16x8 (&qr)[4], f32x16 (&o)[2], float& m_out, float& l_out,
                    const float slope2, const int tpos, ALAS float* wsf, const int wid, const int lane) {
    const int r32 = lane & 31, hi = lane >> 5, NT = seq.NT;
    const unsigned kdst = (unsigned)(uintptr_t)(L + L_K) + (unsigned)wid * 1024u, vdst = (unsigned)(uintptr_t)(L + L_V) + (unsigned)wid * 1024u;
    const unsigned koff = (unsigned)(lane * 64 + wid * 8) * 2u, voff = (unsigned)((16 * (wid & 3) + (lane >> 2)) * 64 + (wid >> 2) * 32 + (lane & 3) * 8) * 2u;
#define PP_DMA_K(d, slot) glds16s(Kb + (size_t)__builtin_amdgcn_readfirstlane(seq.krow(d)) * 64, koff, (unsigned)__builtin_amdgcn_readfirstlane((int)(kdst + (unsigned)(slot))))
#define PP_DMA_V(d, slot) glds16s(Vb + (size_t)__builtin_amdgcn_readfirstlane(seq.krow(d)) * 64, voff, (unsigned)__builtin_amdgcn_readfirstlane((int)(vdst + (unsigned)(slot))))
    const lchar* vp0 = L + L_V + ((lane >> 4) & 1) * 32 + (lane & 3) * 8 + (4 * hi + ((lane & 15) >> 2)) * 64;
    const lchar* kp0 = L + L_K + hi * 1024 + r32 * 16;
    const float posf = (float)(-tpos);
    const unsigned kb16_ = (unsigned)f2bf((float)r32), kb16b_ = (unsigned)f2bf((float)(r32 + 32));
    const unsigned ka0 = hi ? 0u : kb16_ * 0x10001u, ka1 = hi ? 0u : kb16b_ * 0x10001u, kc1 = hi ? 0u : 0x3F803F80u, kc2 = hi ? 0u : 0x00003F80u;
    unsigned qw0, qw1 = 0u, qw2 = 0u;
    { const unsigned h_ = (unsigned)f2bf(slope2); const float rem_ = slope2 - bf2f((bf16_t)h_); qw0 = h_ | ((unsigned)f2bf(rem_) << 16); }
#define PP_CB(d) (seq.vis(d) ? slope2 * ((float)seq.krow(d) + posf) : NEG)
#define PP_QB(cb_) do { const float c0_ = (cb_); const unsigned h1_ = __float_as_uint(c0_) & 0xffff0000u; const float r1_ = c0_ - __uint_as_float(h1_); \
        const unsigned h2_ = __float_as_uint(r1_) & 0xffff0000u; const float r2_ = r1_ - __uint_as_float(h2_); qw1 = __builtin_amdgcn_perm(h2_, h1_, 0x07060302u); qw2 = __float_as_uint(r2_) >> 16; } while (0)
#define PP_BIAS(C0, C1) do { u32x4 ka_ = {ka0, kc1, kc2, 0u}, kb_ = {ka1, kc1, kc2, 0u}; const u32x4 qb_ = {qw0, qw1, qw2, 0u}; \
        C0 = ATT_MFMA(__builtin_bit_cast(bf16x8, ka_), __builtin_bit_cast(bf16x8, qb_), C0); C1 = ATT_MFMA(__builtin_bit_cast(bf16x8, kb_), __builtin_bit_cast(bf16x8, qb_), C1); } while (0)
#define PP_BIAS0(C0, C1) do { u32x4 ka_ = {ka0, kc1, kc2, 0u}, kb_ = {ka1, kc1, kc2, 0u}; const u32x4 qb_ = {qw0, qw1, qw2, 0u}; \
        C0 = ATT_MFMA(__builtin_bit_cast(bf16x8, ka_), __builtin_bit_cast(bf16x8, qb_), Z16); C1 = ATT_MFMA(__builtin_bit_cast(bf16x8, kb_), __builtin_bit_cast(bf16x8, qb_), Z16); } while (0)
    const f32x16 Z16 = {0.f, 0.f, 0.f, 0.f, 0.f, 0.f, 0.f, 0.f, 0.f, 0.f, 0.f, 0.f, 0.f, 0.f, 0.f, 0.f};
#define PP_LIT(r) ((float)(((r) & 3) + 8 * ((r) >> 2)))
    float mhat = 0.f, l_reg = 0.f; bool resc = false;
    f32x16 pA0, pA1, pB0, pB1; bf16x8 kf[8]; s16x4 vlo[8], vhi[8]; u32x4 pw0, pw1, pw2, pw3;
    int sl_prev = 0, sl_cur = 0, sl_next = 8192;
#define PP_ROT() do { sl_prev = sl_cur; sl_cur = sl_next; sl_next = (sl_next == 16384) ? 0 : sl_next + 8192; } while (0)
    int d_0 = seq.desc(0), d_1 = seq.desc(1), d_2 = seq.desc(2), d_3 = seq.desc(3);
    asm volatile("s_waitcnt vmcnt(0)" ::: "memory");
    PP_DMA_K(d_0, 0); PP_DMA_V(d_0, 0); if (NT > 1) PP_DMA_K(d_1, 8192); if (NT > 2) PP_DMA_K(d_2, 16384);
    PP_QB(PP_CB(d_0));
    ATT_WAIT_BAR_N(1 + (NT > 1 ? 1 : 0) + (NT > 2 ? 1 : 0));
#pragma unroll
    for (int d0 = 0; d0 < 4; ++d0) kload2(kf, kp0, d0);
#pragma unroll
    for (int d0 = 0; d0 < 4; ++d0) { pA0 = ATT_MFMA(kf[2 * d0], qr[d0], d0 ? pA0 : Z16); pA1 = ATT_MFMA(kf[2 * d0 + 1], qr[d0], d0 ? pA1 : Z16); }
    PP_BIAS(pA0, pA1);
    if (seq.emask(d_0)) emask_apply(pA0, pA1, seq.lo(d_0), seq.hi_(d_0), hi);
    { mhat = max2f(rowmax32(pA0, pA1), MFLOOR);
#pragma unroll
      for (int r = 0; r < 16; ++r) { pA0[r] = __builtin_amdgcn_exp2f(pA0[r] - mhat); pA1[r] = __builtin_amdgcn_exp2f(pA1[r] - mhat); } }
    ATT_WAIT_BAR(0);
    if (NT > 3) PP_DMA_K(d_3, 0);
    if (NT > 1) { PP_DMA_V(d_1, 8192); PP_ROT();
#pragma unroll
        for (int d0 = 0; d0 < 4; ++d0) kload2(kf, kp0 + sl_cur, d0);
        PP_QB(PP_CB(d_1) - mhat); }
    ATT_WAIT_BAR_N((NT > 3 ? 1 : 0) + (NT > 1 ? 1 : 0));
    d_0 = d_1; d_1 = d_2; d_2 = d_3; d_3 = seq.desc(4);
#define PP_PKW(P, i) cvtpk(P[i], P[i + 1])
#define PP_PAF(k) __builtin_bit_cast(bf16x8, pw##k)
#define PP_VFR(i) (bf16x8){vlo[i][0], vlo[i][1], vlo[i][2], vlo[i][3], vhi[i][0], vhi[i][1], vhi[i][2], vhi[i][3]}
#define PP_VRD(i) do { vlo[i] = vtr(vp_ + (((i) >> 2) * 4096 + ((i) & 3) * 1024)); vhi[i] = vtr(vp_ + (((i) >> 2) * 4096 + ((i) & 3) * 1024 + 512)); } while (0)
#define PP_KRD(d0) do { kload2(kf, kp0 + sl_next, d0); SBAR(); } while (0)
#define PP_GAPA(MF, a0, a1, a2, a3, W0, W1, PW) do { MF; sacc += a0; sacc += a1; sacc += a2; sacc += a3; W0; W1; PIN(PW); PIN(sacc); SBAR(); } while (0)
#define PP_GAPA2(MF, a0, a1, W0, W1, PW) do { MF; sacc += a0; sacc += a1; W0; W1; PIN(PW); PIN(sacc); SBAR(); } while (0)
#define PP_GAPB(MF, X, Y, i, off) do { MF; X[i] = __builtin_amdgcn_exp2f(X[i]); X[i + 1] = __builtin_amdgcn_exp2f(X[i + 1]); X[i + 2] = __builtin_amdgcn_exp2f(X[i + 2]); X[i + 3] = __builtin_amdgcn_exp2f(X[i + 3]); PIN(X); SBAR(); } while (0)
#define PP_STEP(C0, C1, P0, P1, t) do { SBAR(); \
    PP_BIAS0(C0, C1); float cb1_ = PP_CB(d_1); PIN(cb1_); SBAR();                                \
    const lchar* vp_ = vp0 + sl_prev; \
    PP_VRD(0); SBAR(); float sacc = P0[0] + P0[1]; \
                       PP_GAPA(C0 = ATT_MFMA(kf[0], qr[0], C0), P0[2], P0[3], P0[4], P0[5],     pw0[0] = PP_PKW(P0, 0),  pw0[1] = PP_PKW(P0, 2),  pw0); \
    PP_VRD(4); SBAR(); PP_GAPA(C1 = ATT_MFMA(kf[1], qr[0], C1), P0[6], P0[7], P0[8], P0[9],     pw0[2] = PP_PKW(P0, 4),  pw0[3] = PP_PKW(P0, 6),  pw0); \
    PP_VRD(1); SBAR(); PP_GAPA(C0 = ATT_MFMA(kf[2], qr[1], C0), P0[10], P0[11], P0[12], P0[13], pw1[0] = PP_PKW(P0, 8),  pw1[1] = PP_PKW(P0, 10), pw1); \
    PP_VRD(5); SBAR(); PP_GAPA(C1 = ATT_MFMA(kf[3], qr[1], C1), P0[14], P0[15], P1[0], P1[1],   pw1[2] = PP_PKW(P0, 12), pw1[3] = PP_PKW(P0, 14), pw1); \
    PP_VRD(2); SBAR(); PP_GAPA(C0 = ATT_MFMA(kf[4], qr[2], C0), P1[2], P1[3], P1[4], P1[5],     pw2[0] = PP_PKW(P1, 0),  pw2[1] = PP_PKW(P1, 2),  pw2); \
    PP_VRD(6); SBAR(); PP_GAPA(C1 = ATT_MFMA(kf[5], qr[2], C1), P1[6], P1[7], P1[8], P1[9],     pw2[2] = PP_PKW(P1, 4),  pw2[3] = PP_PKW(P1, 6),  pw2); \
    PP_VRD(3); SBAR(); PP_GAPA(C0 = ATT_MFMA(kf[6], qr[3], C0), P1[10], P1[11], P1[12], P1[13], pw3[0] = PP_PKW(P1, 8),  pw3[1] = PP_PKW(P1, 10), pw3); \
    PP_VRD(7); SBAR(); PP_GAPA2(C1 = ATT_MFMA(kf[7], qr[3], C1), P1[14], P1[15],                pw3[2] = PP_PKW(P1, 12), pw3[3] = PP_PKW(P1, 14), pw3); \
    l_reg += sacc; \
    const bool ik_ = (t) + 3 < NT, iv_ = (t) + 1 < NT; \
    if (ik_) PP_DMA_K(d_3, sl_cur); if (iv_) PP_DMA_V(d_1, sl_next);                                     \
    if (seq.emask(d_0)) emask_apply(C0, C1, seq.lo(d_0), seq.hi_(d_0), hi); \
    { const float rm = rowmax32(C0, C1); resc = false;                                                   \
      if (__builtin_expect(__any(rm > THR), 0)) { const float dl = max2f(rm, 0.f); mhat += dl;           \
          const float f = __builtin_amdgcn_exp2f(-dl); l_reg *= f; if (hi == 0) wsf[r32] = f; resc = true; \
          _Pragma("unroll") for (int r = 0; r < 16; ++r) { C0[r] -= dl; C1[r] -= dl; } } } \
    PP_QB(cb1_ - mhat); const int d_4 = seq.desc((t) + 4); SBAR(); \
    PP_GAPB(o[0] = ATT_MFMA(PP_PAF(0), PP_VFR(0), o[0]), C0, P0, 0, 0.f);               PP_GAPB(o[1] = ATT_MFMA(PP_PAF(0), PP_VFR(4), o[1]), C0, P0, 4, 0.f); \
    PP_KRD(0); PP_GAPB(o[0] = ATT_MFMA(PP_PAF(1), PP_VFR(1), o[0]), C0, P0, 8, 0.f);    PP_KRD(1); PP_GAPB(o[1] = ATT_MFMA(PP_PAF(1), PP_VFR(5), o[1]), C0, P0, 12, 0.f); \
    PP_KRD(2); PP_GAPB(o[0] = ATT_MFMA(PP_PAF(2), PP_VFR(2), o[0]), C1, P1, 0, 32.f);   PP_KRD(3); PP_GAPB(o[1] = ATT_MFMA(PP_PAF(2), PP_VFR(6), o[1]), C1, P1, 4, 32.f); \
    PP_GAPB(o[0] = ATT_MFMA(PP_PAF(3), PP_VFR(3), o[0]), C1, P1, 8, 32.f);              PP_GAPB(o[1] = ATT_MFMA(PP_PAF(3), PP_VFR(7), o[1]), C1, P1, 12, 32.f); \
    ATT_WAIT_BAR_N((ik_ ? 1 : 0) + (iv_ ? 1 : 0));                                                        \
    if (resc) { _Pragma("unroll") for (int d_ = 0; d_ < 2; ++d_) _Pragma("unroll") for (int r = 0; r < 16; ++r) o[d_][r] *= wsf[crow(r, hi)]; } \
    PP_ROT(); d_0 = d_1; d_1 = d_2; d_2 = d_3; d_3 = d_4; \
    } while (0)
#define PP_DRAIN(P0, P1) do { float sacc = P0[0] + P0[1]; \
      _Pragma("unroll") for (int r = 2; r < 16; ++r) sacc += P0[r]; \
      _Pragma("unroll") for (int r = 0; r < 16; ++r) sacc += P1[r]; \
      l_reg += sacc; \
      pw0 = (u32x4){PP_PKW(P0, 0), PP_PKW(P0, 2), PP_PKW(P0, 4), PP_PKW(P0, 6)}; pw1 = (u32x4){PP_PKW(P0, 8), PP_PKW(P0, 10), PP_PKW(P0, 12), PP_PKW(P0, 14)}; \
      pw2 = (u32x4){PP_PKW(P1, 0), PP_PKW(P1, 2), PP_PKW(P1, 4), PP_PKW(P1, 6)}; pw3 = (u32x4){PP_PKW(P1, 8), PP_PKW(P1, 10), PP_PKW(P1, 12), PP_PKW(P1, 14)}; \
      const lchar* vp_ = vp0 + sl_prev; _Pragma("unroll") for (int i = 0; i < 8; ++i) PP_VRD(i); \
      o[0] = ATT_MFMA(PP_PAF(0), PP_VFR(0), o[0]); o[1] = ATT_MFMA(PP_PAF(0), PP_VFR(4), o[1]); o[0] = ATT_MFMA(PP_PAF(1), PP_VFR(1), o[0]); o[1] = ATT_MFMA(PP_PAF(1), PP_VFR(5), o[1]); \
      o[0] = ATT_MFMA(PP_PAF(2), PP_VFR(2), o[0]); o[1] = ATT_MFMA(PP_PAF(2), PP_VFR(6), o[1]); o[0] = ATT_MFMA(PP_PAF(3), PP_VFR(3), o[0]); o[1] = ATT_MFMA(PP_PAF(3), PP_VFR(7), o[1]); } while (0)
    int t = 1;
#pragma unroll 1
    for (; t + 1 < NT; t += 2) {
        PP_STEP(pB0, pB1, pA0, pA1, t);
        PP_STEP(pA0, pA1, pB0, pB1, t + 1);
    }
    if (t < NT) { PP_STEP(pB0, pB1, pA0, pA1, t); SBAR(); PP_DRAIN(pB0, pB1); }
    else { SBAR(); PP_DRAIN(pA0, pA1); }
    m_out = mhat; l_out = l_reg;
    ATT_BAR();
#undef PP_DMA_K
#undef PP_DMA_V
#undef PP_CB
#undef PP_QB
#undef PP_BIAS
#undef PP_BIAS0
#undef PP_ROT
#undef PP_STEP
#undef PP_DRAIN
}
struct NsaSeq {
    int vlist, NT; unsigned long long rmask; int c, tokloc, wblk;
    DEVI int desc(int i) const { return __builtin_amdgcn_readlane(vlist, i & 63); }
    DEVI int krow(int d) const { return 64 * (d & 63); }
    DEVI bool vis(int d) const { return !(d & 64) && ((rmask >> (d & 63)) & 1ull); }
    DEVI bool emask(int d) const { return d == c || d == wblk; }
    DEVI int lo(int d) const { return d == wblk ? tokloc + 1 : -BIG; }
    DEVI int hi_(int d) const { return d == c ? tokloc : BIG; }
};
struct MobaSeq {
    int cur, NT, widh, tq; unsigned sel;
    DEVI int desc(int i) const { return i; }
    DEVI int krow(int i) const { return (cur + 1) * 256 - 64 * (i + 1); }
    DEVI bool own(int i) const { return i < 4; }
    DEVI bool vis(int i) const { return own(i) ? ((3 - i) <= widh) : (((sel >> ((cur - (i >> 2)) & 31)) & 1u) != 0u); }
    DEVI bool emask(int i) const { return own(i) && (3 - i) == widh; }
    DEVI int lo(int) const { return -BIG; }
    DEVI int hi_(int i) const { return tq - 64 * (3 - i); }
};

template <class RowF>
DEVI void store_y(const ALAS float* ot, const bf16_t* Zb, bf16_t* Y, const RowF& rf, int lane) {
    u32x4 z[4];
#pragma unroll
    for (int i = 0; i < 4; ++i) { const int ci = i * 64 + lane, q = ci >> 3, ch = ci & 7; z[i] = *(const u32x4*)(Zb + rf.zoff(q) + ch * 8); }
#pragma unroll
    for (int i = 0; i < 4; ++i) {
        const int ci = i * 64 + lane, q = ci >> 3, ch = ci & 7;
        const f32x4 v0 = *(const ALAS f32x4*)(ot + q * 64 + ch * 8), v1 = *(const ALAS f32x4*)(ot + q * 64 + ch * 8 + 4);
        u32x4 w;
        w.x = cvtpk(v0[0] * __uint_as_float(z[i].x << 16), v0[1] * __uint_as_float(z[i].x & 0xffff0000u)); w.y = cvtpk(v0[2] * __uint_as_float(z[i].y << 16), v0[3] * __uint_as_float(z[i].y & 0xffff0000u));
        w.z = cvtpk(v1[0] * __uint_as_float(z[i].z << 16), v1[1] * __uint_as_float(z[i].z & 0xffff0000u)); w.w = cvtpk(v1[2] * __uint_as_float(z[i].w << 16), v1[3] * __uint_as_float(z[i].w & 0xffff0000u));
        *(u32x4*)(Y + rf.yoff(q) + ch * 8) = w;
    }
    ATT_LSYNC();
}

struct NsaRows { size_t hs; int rowb, g; DEVI size_t zoff(int q) const { return (size_t)(g * 4 + (q & 3)) * hs + (size_t)(rowb + (q >> 2)) * 64; } DEVI size_t yoff(int q) const { return (size_t)(rowb + (q >> 2)) * 1024 + (g * 4 + (q & 3)) * 64; } };
struct MobaRows { size_t hs; int rowb, h; DEVI size_t zoff(int q) const { return (size_t)(8 + h) * hs + (size_t)(rowb + q) * 64; } DEVI size_t yoff(int q) const { return (size_t)(rowb + q) * 1024 + 512 + h * 64; } };

DEVI void nsa_unit(const Params& P, lchar* L, const int b, const int g, const int c, const int wid) {
    const int lane = lane_id_opaque(), r32 = lane & 31, hi = lane >> 5;
    const bf16_t* ATT = (const bf16_t*)(P.ws + WS_ATT); const size_t HS = (size_t)MROWS * 64;
    lchar* Wv = L + L_WAVE + wid * WAVE_BYTES;
    ALAS float* wsf = (ALAS float*)(Wv + W_WSF); ALAS float* IMP = (ALAS float*)(Wv + W_IMP);
    ALAS unsigned long long* MASKS = (ALAS unsigned long long*)(Wv + W_MASK); ALAS float* OT = (ALAS float*)(Wv + W_OT);
    ALAS unsigned long long* WUN = (ALAS unsigned long long*)(L + L_WG);
    const int tokloc = wid * 8 + (r32 >> 2), hh = g * 4 + (r32 & 3);
    const int t = c * 64 + tokloc, row = b * SEQ + t;
    const float slope2 = exp2f(-(float)(2 * hh + 1) * 0.5f) * LOG2E;
    bf16x8 qr[4];
    { const bf16_t* qp = ATT + (size_t)(HC_QA + hh) * HS + (size_t)row * 64 + hi * 8;
#pragma unroll
      for (int d0 = 0; d0 < 4; ++d0) qr[d0] = *(const bf16x8*)(qp + d0 * 16); }
    const float* Gp = (const float*)(P.ws + WS_G) + (size_t)row * 24 + hh;
    unsigned long long U, wun = 0ull, mymask;
    Stage st;
    {
        const bf16_t* KCb = (const bf16_t*)(P.ws + WS_KC) + (size_t)(b * 2 + g) * 256 * 64; const bf16_t* VCb = (const bf16_t*)(P.ws + WS_VC) + (size_t)(b * 2 + g) * 256 * 64;
        const int nblk = ((4 * c + 2) >> 6) + 1, nlim = (t - 31) >> 4;
        f32x16 o[4];
#pragma unroll
        for (int d = 0; d < 4; ++d)
#pragma unroll
            for (int r = 0; r < 16; ++r) o[d][r] = 0.f;
        float m = 0.f, l = 0.f; bool first = true;
#define OV_TILE(bb, dstoff) do { const int p_ = wid * 64 + lane, dh_ = p_ >> 8, kk_ = (p_ >> 2) & 63, c4_ = p_ & 3, n_ = 64 * (bb) + kk_; \
            const int jr_ = (n_ >> 2) - (dh_ * 32 + c4_ * 8);                           \
            unsigned m8_ = ((unsigned)jr_ < 8u ? 1u << jr_ : 0u) | (((n_ & 3) == 3 && (unsigned)(jr_ + 1) < 8u) ? 1u << (jr_ + 1) : 0u); if (n_ >= 255) m8_ = 0u; \
            unsigned w_[4]; _Pragma("unroll") for (int e_ = 0; e_ < 4; ++e_) w_[e_] = ((m8_ >> (2 * e_)) & 1u) * 0x3F80u | ((m8_ >> (2 * e_ + 1)) & 1u) * 0x3F800000u; \
            *(ALAS u32x4*)(L + L_OVT + (dstoff) + dh_ * 4096 + kk_ * 64 + c4_ * 16) = (u32x4){w_[0], w_[1], w_[2], w_[3]}; } while (0)
        stage_load(st, KCb, VCb, wid, lane); stage_write(st, L + L_K, L + L_V, wid, lane); OV_TILE(0, 0); ATT_BAR();
        for (int i = 0; i < nblk; ++i) {
            const int buf = i & 1;
            if (i + 1 < nblk) stage_load(st, KCb + (i + 1) * 4096, VCb + (i + 1) * 4096, wid, lane);
            const float cbase = slope2 * (float)(16 * (64 * i + 4 * hi) + 31 - t);
            flash_block<4, true>(L + L_K + buf * 8192, L + L_V + buf * 8192, L + L_OVT + buf * 8192, qr, o, m, l, first, cbase, slope2 * 16.f, -BIG, nlim - 64 * i, wsf, lane);
            first = false;
            __builtin_amdgcn_sched_barrier(0);
            if (i + 1 < nblk) { stage_write(st, L + L_K + (buf ^ 1) * 8192, L + L_V + (buf ^ 1) * 8192, wid, lane); OV_TILE(i + 1, (buf ^ 1) * 8192); }
            ATT_BAR();
        }
        const float lt = swap_sum(l), rl = lt > 0.f ? 1.f / lt : 0.f;
        wsf[r32] = Gp[0] * rl; wsf[64 + r32] = rl; ATT_LSYNC();
#pragma unroll
        for (int d0 = 0; d0 < 2; ++d0)
#pragma unroll
            for (int r = 0; r < 16; ++r) OT[crow(r, hi) * 64 + d0 * 32 + r32] = o[d0][r] * wsf[crow(r, hi)];
#pragma unroll
        for (int d0 = 0; d0 < 2; ++d0)
#pragma unroll
            for (int g4 = 0; g4 < 4; ++g4) { float v = 0.f;
#pragma unroll
                for (int p = 0; p < 4; ++p) v += o[2 + d0][4 * g4 + p] * wsf[64 + crow(4 * g4 + p, hi)];
                IMP[(2 * g4 + hi) * 64 + d0 * 32 + r32] = v; }
        ATT_LSYNC();
#pragma unroll 1
        for (int tk = 0; tk < 8; ++tk) {
            float v = IMP[tk * 64 + lane];
            if (lane == 0 || lane == c || lane == c - 1) v = INFINITY;
            if (lane > c) v = -INFINITY;
            const unsigned bits = __float_as_uint(v), key = bits ^ ((bits & 0x80000000u) ? 0xffffffffu : 0x80000000u);
            unsigned T = 0u;
#pragma unroll 1
            for (int bit = 31; bit >= 0; --bit) { const unsigned cand = T | (1u << bit); const int cnt = __builtin_popcountll(__ballot(key >= cand)); if (cnt >= 16) { T = cand; if (cnt == 16) break; } }
            const unsigned long long gt = __ballot(key > T), eq = __ballot(key == T);
            const int need = 16 - __builtin_popcountll(gt);
            const int below = (int)__builtin_amdgcn_mbcnt_hi((unsigned)(eq >> 32), __builtin_amdgcn_mbcnt_lo((unsigned)eq, 0u));
            const bool selj = (key > T) || (key == T && below < need);
            const unsigned long long mk = __ballot(selj && lane <= c);
            if (lane == 0) MASKS[tk] = mk;
            wun |= mk; }
        if (lane == 0) WUN[wid] = wun;
        ATT_BAR();
        U = 0ull;
#pragma unroll
        for (int w = 0; w < 8; ++w) U |= WUN[w];
        U = ((unsigned long long)(unsigned)__builtin_amdgcn_readfirstlane((int)(U >> 32)) << 32) | (unsigned long long)(unsigned)__builtin_amdgcn_readfirstlane((int)(unsigned)U);
    }
    const int laneB = lane_id_opaque(), r32B = laneB & 31, hiB = laneB >> 5, toklocB = wid * 8 + (r32B >> 2), hhB = g * 4 + (r32B & 3), tB = c * 64 + toklocB;
    const float slope2B = exp2f(-(float)(2 * hhB + 1) * 0.5f) * LOG2E;
    const float* GpB = (const float*)(P.ws + WS_G) + (size_t)(b * SEQ + tB) * 24 + hhB;
    mymask = MASKS[r32B >> 2];
#pragma unroll
    for (int pass = 1; pass <= 2; ++pass) {
        const bf16_t* Kb = ATT + (size_t)((pass == 1 ? HC_KS : HC_KW) + g) * HS + (size_t)b * SEQ * 64;
        const bf16_t* Vb = ATT + (size_t)((pass == 1 ? HC_VS : HC_VW) + g) * HS + (size_t)b * SEQ * 64;
        const int jlow = c >= 8 ? c - 8 : 0;
        const unsigned long long upto = (c == 63) ? ~0ull : ((1ull << (c + 1)) - 1ull);
        const unsigned long long Ucur = (pass == 1) ? U : (upto & ~((1ull << jlow) - 1ull));
        const unsigned long long wneed = (pass == 1) ? wun : ~0ull, rmask = (pass == 1) ? mymask : ~0ull;
        f32x16 o[2];
#pragma unroll
        for (int d = 0; d < 2; ++d)
#pragma unroll
            for (int r = 0; r < 16; ++r) o[d][r] = 0.f;
        float m = 0.f, l = 0.f;
        ALAS unsigned char* TL = (ALAS unsigned char*)(L + L_TL);
        const int ntraw = (int)__builtin_popcountll(Ucur);
        if (wid == 0 && laneB == 0) TL[ntraw] = (unsigned char)64;
        if (wid == 0 && ((Ucur >> laneB) & 1ull)) TL[__builtin_popcountll(laneB == 63 ? 0ull : (Ucur >> (laneB + 1)))] = (unsigned char)laneB;
        ATT_BAR();
        const NsaSeq seq{(int)TL[laneB], ntraw, rmask, c, toklocB, (pass == 2 && c >= 8) ? c - 8 : -1};
        pipe_pass(L, seq, Kb, Vb, qr, o, m, l, slope2B, tB, wsf, wid, laneB);
        const float lt = swap_sum(l), rl = lt > 0.f ? 1.f / lt : 0.f;
        wsf[r32B] = GpB[8 * pass] * rl; ATT_LSYNC();
#pragma unroll
        for (int d0 = 0; d0 < 2; ++d0)
#pragma unroll
            for (int r = 0; r < 16; ++r) OT[crow(r, hiB) * 64 + d0 * 32 + r32B] += o[d0][r] * wsf[crow(r, hiB)];
        ATT_LSYNC();
    }
    const NsaRows rf{HS, b * SEQ + c * 64 + wid * 8, g};
    store_y(OT, (const bf16_t*)(P.ws + WS_Z), (bf16_t*)(P.ws + WS_Y), rf, laneB);
}

DEVI void moba_unit(const Params& P, lchar* L, const int b, const int h, const int cur, const int wid) {
    const int lane = lane_id_opaque(), r32 = lane & 31, hi = lane >> 5; const int tid = wid * 64 + lane;
    const bf16_t* ATT = (const bf16_t*)(P.ws + WS_ATT); const size_t HS = (size_t)MROWS * 64;
    lchar* Wv = L + L_WAVE + wid * WAVE_BYTES;
    ALAS float* wsf = (ALAS float*)(Wv + W_WSF); ALAS float* OT = (ALAS float*)(Wv + W_OT);
    const int tq = 32 * wid + r32, t = cur * 256 + tq, row = b * SEQ + t;
    const float slope2 = exp2f(-(float)(h + 1)) * LOG2E;
    bf16x8 qr[4];
    { const bf16_t* qp = ATT + (size_t)(HC_QB + h) * HS + (size_t)row * 64 + hi * 8;
#pragma unroll
      for (int d0 = 0; d0 < 4; ++d0) qr[d0] = *(const bf16x8*)(qp + d0 * 16); }
    unsigned sel = 0u;
    if (cur > 0) {
        const float* kbp = (const float*)(P.ws + WS_KBAR) + (size_t)((b * 8 + h) * 16) * 64;
        lchar* KH = L + L_KBT; lchar* KL = L + L_KBT + 4096;
        for (int e = tid; e < 1024; e += NT) { const int key = e >> 6, d = e & 63; const float v = kbp[e]; const bf16_t vh = f2bf(v), vl = f2bf(v - bf2f(vh));
            const int off = (d >> 3) * 512 + key * 16 + (d & 7) * 2; *(ALAS bf16_t*)(KH + off) = vh; *(ALAS bf16_t*)(KL + off) = vl; }
        ATT_BAR();
        f32x16 ga;
#pragma unroll
        for (int r = 0; r < 16; ++r) ga[r] = 0.f;
        const lchar* kh = KH + hi * 512 + r32 * 16; const lchar* kl = KL + hi * 512 + r32 * 16;
#pragma unroll
        for (int d0 = 0; d0 < 4; ++d0) { ga = ATT_MFMA(*(const ALAS bf16x8*)(kh + d0 * 1024), qr[d0], ga); ga = ATT_MFMA(*(const ALAS bf16x8*)(kl + d0 * 1024), qr[d0], ga); }
        float own[8], oth[8], G[16];
#pragma unroll
        for (int r = 0; r < 8; ++r) { own[r] = ga[r]; oth[r] = swap_other(own[r], hi); }
#pragma unroll
        for (int idx = 0; idx < 16; ++idx) { const int half = (idx >> 2) & 1, rs = (idx & 3) + 4 * (idx >> 3); const float v = (half == hi) ? own[rs] : oth[rs]; G[idx] = (idx < cur) ? v : -INFINITY; }
#pragma unroll
        for (int k = 0; k < 3; ++k) { float best = -INFINITY; int bi = -1;
#pragma unroll
            for (int idx = 0; idx < 16; ++idx) { const bool ok = (G[idx] > best) && !((sel >> idx) & 1u); best = ok ? G[idx] : best; bi = ok ? idx : bi; }
            if (bi >= 0) sel |= 1u << bi; }
    }
    const bf16_t* Kb = ATT + (size_t)(HC_KB + h) * HS + (size_t)b * SEQ * 64; const bf16_t* Vb = ATT + (size_t)(HC_VB + h) * HS + (size_t)b * SEQ * 64;
    f32x16 o[2];
#pragma unroll
    for (int d = 0; d < 2; ++d)
#pragma unroll
        for (int r = 0; r < 16; ++r) o[d][r] = 0.f;
    float m = 0.f, l = 0.f;
    const MobaSeq seq{cur, 4 * (cur + 1), wid >> 1, tq, sel};
    pipe_pass(L, seq, Kb, Vb, qr, o, m, l, slope2, t, wsf, wid, lane);
    const float lt = swap_sum(l), rl = lt > 0.f ? 1.f / lt : 0.f;
    wsf[r32] = rl; ATT_LSYNC();
#pragma unroll
    for (int d0 = 0; d0 < 2; ++d0)
#pragma unroll
        for (int r = 0; r < 16; ++r) OT[crow(r, hi) * 64 + d0 * 32 + r32] = o[d0][r] * wsf[crow(r, hi)];
    ATT_LSYNC();
    const MobaRows rf{HS, b * SEQ + cur * 256 + wid * 32, h};
    store_y(OT, (const bf16_t*)(P.ws + WS_Z), (bf16_t*)(P.ws + WS_Y), rf, lane);
}


DEVI void phase_compress(const Params& P, lchar* L, const int wid) {
    const int lane = lane_id_opaque(), r32 = lane & 31, hi = lane >> 5;
    const bf16_t* ATT = (const bf16_t*)(P.ws + WS_ATT); const size_t HS = (size_t)MROWS * 64;
    constexpr int HP = 272;
    const int wm = wid >> 2, wn = wid & 3;
#pragma unroll 1
    for (int item = blockIdx.x; item < 256; item += gridDim.x) {
        const int q = item & 3, inst = item >> 2, g = inst & 1, b = (inst >> 1) & 15, which = inst >> 5;
        const bf16_t* X = ATT + (size_t)((which ? HC_VCMP : HC_KCMP) + g) * HS + (size_t)b * SEQ * 64;
        const bf16_t* W1T = (const bf16_t*)(P.ws + (which ? WS_W1V : WS_W1K)); const bf16_t* W2T = (const bf16_t*)(P.ws + (which ? WS_W2V : WS_W2K));
        const float* B1P = (const float*)(P.ws + WS_B1P) + which * 8 * 128;
        bf16_t* OUT = (bf16_t*)(P.ws + (which ? WS_VC : WS_KC)) + (size_t)((b * 2 + g) * 256 + 64 * q) * 64;
        const int n0 = 64 * q + 32 * wm, e0 = 32 * wn;
        f32x16 acc;
#pragma unroll
        for (int r = 0; r < 16; ++r) acc[r] = 0.f;
        {
            constexpr int SLOT = 24576, XO = 16384, HOFF = 4 * SLOT;
            const unsigned lbase = (unsigned)(uintptr_t)L;
            const int ul = lane >> 4, sl = lane & 15;
            unsigned woff[2], xoff;
#pragma unroll
            for (int j = 0; j < 2; ++j) { const int u = 4 * wid + ul + 32 * j, val = sl ^ (u & 15); woff[j] = (unsigned)((2 * u + (val >> 3)) * 4096 + (val & 7) * 16); }
            { const int u = 4 * wid + ul, val = sl ^ (u & 15); xoff = (unsigned)((2 * u + (val >> 3)) * 2048 + (val & 7) * 16); }
            const char* Wb = (const char*)W1T; const char* Xb = (const char*)(X + (size_t)(64 * q) * 1024);
#define CMP_ISSUE(c_) do { const unsigned d_ = lbase + (unsigned)(((c_) & 3) * SLOT) + (unsigned)wid * 1024u; \
                glds16s(Wb + (size_t)(c_) * 128, woff[0], (unsigned)__builtin_amdgcn_readfirstlane((int)d_)); glds16s(Wb + (size_t)(c_) * 128, woff[1], (unsigned)__builtin_amdgcn_readfirstlane((int)(d_ + 8192u))); \
                glds16s(Xb + (size_t)(c_) * 128, xoff, (unsigned)__builtin_amdgcn_readfirstlane((int)(d_ + (unsigned)XO))); } while (0)
            int aad[4], bad[4];
            { const int ra = e0 + r32, ua = ra >> 1, ca = (((ra & 1) << 3) | hi) ^ (ua & 15); const int rb = 32 * wm + r32, ub = rb >> 1, cb = (((rb & 1) << 3) | hi) ^ (ub & 15);
#pragma unroll
              for (int ks = 0; ks < 4; ++ks) { aad[ks] = ua * 256 + ((ca ^ (2 * ks)) * 16); bad[ks] = XO + ub * 256 + ((cb ^ (2 * ks)) * 16); } }
            asm volatile("s_waitcnt vmcnt(0)" ::: "memory");
            CMP_ISSUE(0); CMP_ISSUE(1); CMP_ISSUE(2);
#pragma unroll 1
            for (int c = 0; c < 32; ++c) {
                if (c + 2 < 32) asm volatile("s_waitcnt vmcnt(6) lgkmcnt(0)\n\ts_barrier" ::: "memory");
                else if (c + 1 < 32) asm volatile("s_waitcnt vmcnt(3) lgkmcnt(0)\n\ts_barrier" ::: "memory");
                else asm volatile("s_waitcnt vmcnt(0) lgkmcnt(0)\n\ts_barrier" ::: "memory");
                if (c + 3 < 32) CMP_ISSUE(c + 3);
                const lchar* sb = L + (c & 3) * SLOT;
#pragma unroll
                for (int ks = 0; ks < 4; ++ks) { const bf16x8 a = *(const ALAS bf16x8*)(sb + aad[ks]), bb = *(const ALAS bf16x8*)(sb + bad[ks]); acc = ATT_MFMA(a, bb, acc); }
            }
#undef CMP_ISSUE
            (void)HOFF;
        }
#pragma unroll
        for (int g4 = 0; g4 < 4; ++g4) { float v[4];
#pragma unroll
            for (int j = 0; j < 4; ++j) { const int e = e0 + 8 * g4 + 4 * hi + j; float bs = 0.f;
#pragma unroll
                for (int c = 0; c < 8; ++c) bs += B1P[c * 128 + e];
                const float x = acc[4 * g4 + j] + bs; v[j] = x * __builtin_amdgcn_rcpf(1.f + __builtin_amdgcn_exp2f(-1.4426950408889634f * x)); }
            u32x2 w; w.x = cvtpk(v[0], v[1]); w.y = cvtpk(v[2], v[3]);
            *(ALAS u32x2*)(L + 98304 + (32 * wm + r32) * HP + (e0 + 8 * g4 + 4 * hi) * 2) = w; }
        ATT_BAR();
        if (wid < 4) {
            const int wm2 = wid >> 1, f0 = 32 * (wid & 1);
            f32x16 a2;
#pragma unroll
            for (int r = 0; r < 16; ++r) a2[r] = 0.f;
            const lchar* hp = L + 98304 + (32 * wm2 + r32) * HP + hi * 16; const bf16_t* wp = W2T + (size_t)(f0 + r32) * 128 + hi * 8;
#pragma unroll
            for (int ks = 0; ks < 8; ++ks) { const bf16x8 a = *(const ALAS bf16x8*)(hp + ks * 32), bb = *(const bf16x8*)(wp + ks * 16); a2 = ATT_MFMA(a, bb, a2); }
#pragma unroll
            for (int r = 0; r < 16; ++r) { const int nl = 32 * wm2 + crow(r, hi); const bool pad = (64 * q + nl == 255);
                OUT[(size_t)nl * 64 + f0 + r32] = pad ? (bf16_t)0 : f2bf(a2[r]); }
        }
        ATT_BAR();
    }
    { const int gw = blockIdx.x * (NT / 64) + wid, ngw = (gridDim.x * NT) >> 6; float* KBAR = (float*)(P.ws + WS_KBAR);
      for (int it = gw; it < NB * 8 * 16; it += ngw) { const int n = it & 15, h = (it >> 4) & 7, b = it >> 7;
          const bf16_t* src = ATT + ((size_t)(HC_KB + h) * MROWS + (size_t)b * SEQ + n * 256) * 64; float s0 = 0.f, s1 = 0.f, s2 = 0.f, s3 = 0.f;
          for (int r = 0; r < 256; r += 4) { s0 += bf2f(src[r * 64 + lane]); s1 += bf2f(src[(r + 1) * 64 + lane]); s2 += bf2f(src[(r + 2) * 64 + lane]); s3 += bf2f(src[(r + 3) * 64 + lane]); }
          KBAR[(size_t)it * 64 + lane] = ((s0 + s1) + (s2 + s3)) * (1.f / 256.f); } }
}

DEVI void phase_attention(const Params& P, lchar* L, const int wid) {
    const int tid = wid * 64 + lane_id_opaque();
    const int G = gridDim.x, k = blockIdx.x;
    const int nU = (G == 256) ? 8 : ((2048 - k + G - 1) / G);
#pragma unroll 1
    for (int rep_ = 0; rep_ < 1 + PROBE_NSA2; ++rep_)
#pragma unroll 1
    for (int i = 0; i < (NAIVE_NSA ? 0 : nU); ++i) { int bg, c;
        if (G == 256) { bg = k & 31; const int base = k >> 5; c = 8 * i + ((i & 1) ? 7 - base : base); } else { const int u = k + i * G; bg = u & 31; c = u >> 5; }
        nsa_unit(P, L, bg >> 1, bg & 1, c, wid); }
#pragma unroll 1
    for (int rep_ = 0; rep_ < 1 + PROBE_MOBA2; ++rep_)
#pragma unroll 1
    for (int i = 0; i < (NAIVE_MOBA ? 0 : nU); ++i) { int bh, cur;
        if (G == 256) { bh = k & 127; const int base = k >> 7; cur = 2 * i + ((i & 1) ? 1 - base : base); } else { const int u = k + i * G; bh = u & 127; cur = u >> 7; }
        moba_unit(P, L, bh >> 3, bh & 7, cur, wid); }
}
}

DEVI void phase_final(const Params& P, const int wid) {
    const int lane = lane_id_opaque(), gw = blockIdx.x * (NT / 64) + wid, ngw = (gridDim.x * NT) >> 6;
    const float* SS = (const float*)(P.ws + WS_SS); const bf16_t* T = (const bf16_t*)(P.ws + WS_M1);
    constexpr int RF = 4;
    for (int r = gw * RF; r < MROWS; r += RF * ngw) {
        float4 sv[16];
#pragma unroll
        for (int j = 0; j < 16; ++j) sv[j] = *(const float4*)(SS + (size_t)j * MROWS + r);
        uint4 tw[RF][2]; float4 xa[RF][2], xb[RF][2];
#pragma unroll
        for (int q = 0; q < RF; ++q)
#pragma unroll
            for (int j = 0; j < 2; ++j) { const int c = j * 512 + lane * 8; const size_t o = (size_t)(r + q) * DM + c;
                tw[q][j] = *(const uint4*)(T + o); { typedef float f4v_ __attribute__((ext_vector_type(4))); const f4v_ t0_ = __builtin_nontemporal_load((const f4v_*)(P.x + o)), t1_ = __builtin_nontemporal_load((const f4v_*)(P.x + o + 4)); xa[q][j] = make_float4(t0_[0], t0_[1], t0_[2], t0_[3]); xb[q][j] = make_float4(t1_[0], t1_[1], t1_[2], t1_[3]); } }
        float ss[RF] = {0.f, 0.f, 0.f, 0.f};
#pragma unroll
        for (int j = 0; j < 16; ++j) { ss[0] += sv[j].x; ss[1] += sv[j].y; ss[2] += sv[j].z; ss[3] += sv[j].w; }
#pragma unroll
        for (int q = 0; q < RF; ++q) { const float rs = rsqrtf(ss[q] * (1.f / DM) + RMS_EPS); float* orow = P.out + (size_t)(r + q) * DM;
#pragma unroll
            for (int j = 0; j < 2; ++j) { const int c = j * 512 + lane * 8; const float4 g0 = *(const float4*)(P.norm_post + c), g1 = *(const float4*)(P.norm_post + c + 4);
                const uint4 t4 = tw[q][j]; const float4 x0 = xa[q][j], x1 = xb[q][j]; float4 o0, o1;
                o0.x = x0.x + __uint_as_float(t4.x << 16) * rs * g0.x; o0.y = x0.y + __uint_as_float(t4.x & 0xffff0000u) * rs * g0.y; o0.z = x0.z + __uint_as_float(t4.y << 16) * rs * g0.z; o0.w = x0.w + __uint_as_float(t4.y & 0xffff0000u) * rs * g0.w;
                o1.x = x1.x + __uint_as_float(t4.z << 16) * rs * g1.x; o1.y = x1.y + __uint_as_float(t4.z & 0xffff0000u) * rs * g1.y; o1.z = x1.z + __uint_as_float(t4.w << 16) * rs * g1.z; o1.w = x1.w + __uint_as_float(t4.w & 0xffff0000u) * rs * g1.w;
                { typedef float f4v_ __attribute__((ext_vector_type(4))); const f4v_ s0_ = {o0.x, o0.y, o0.z, o0.w}, s1_ = {o1.x, o1.y, o1.z, o1.w}; __builtin_nontemporal_store(s0_, (f4v_*)(orow + c)); __builtin_nontemporal_store(s1_, (f4v_*)(orow + c + 4)); } } }
    }
}

DEVI void tree_barrier(unsigned* ctl, const int wid) {
    asm volatile("s_waitcnt vmcnt(0) lgkmcnt(0)" ::: "memory");
    __builtin_amdgcn_s_barrier();
    if (wid == 0 && lane_id() == 0) {
        __builtin_amdgcn_fence(__ATOMIC_RELEASE, "agent");
        const unsigned G = gridDim.x, ng = G < 16u ? G : 16u, g = blockIdx.x % ng, gsz = G / ng + (g < G % ng ? 1u : 0u);
        const unsigned old = __hip_atomic_fetch_add(ctl + g * 32, 1u, __ATOMIC_RELAXED, __HIP_MEMORY_SCOPE_AGENT);
        if (old == gsz - 1u) {
            const unsigned o2 = __hip_atomic_fetch_add(ctl + 512, 1u, __ATOMIC_RELAXED, __HIP_MEMORY_SCOPE_AGENT);
            if (o2 == ng - 1u) __hip_atomic_store(ctl + 544, 1u, __ATOMIC_RELAXED, __HIP_MEMORY_SCOPE_AGENT);
        }
        while (__hip_atomic_load(ctl + 544, __ATOMIC_RELAXED, __HIP_MEMORY_SCOPE_AGENT) == 0u) __builtin_amdgcn_s_sleep(1);
        __builtin_amdgcn_fence(__ATOMIC_ACQUIRE, "agent");
    }
    __builtin_amdgcn_s_barrier();
}

constexpr int LDS_BYTES = 163840;
__global__ void __launch_bounds__(NT, 2) fwd_kernel(Params P) {
    extern __shared__ __attribute__((aligned(16))) unsigned char lds_raw[];
    float* lds = (float*)lds_raw;
    PG8_LAS unsigned char* ring = (PG8_LAS unsigned char*)lds_raw;
    __builtin_assume(__builtin_amdgcn_workitem_id_y() == 0); __builtin_assume(__builtin_amdgcn_workitem_id_z() == 0);
    cg::grid_group grid = cg::this_grid();
    const int wid = __builtin_amdgcn_readfirstlane(threadIdx.x >> 6);
    const int lo = P.ph_lo, hi = P.ph_hi;
#define IN(k) (lo <= (k) && (k) < hi)
#define SEAM0() do { if (IN(0) && IN(1)) { asm volatile("s_waitcnt vmcnt(0) lgkmcnt(0)" ::: "memory"); grid.sync(); } } while (0)
#define SEAM(k) do { if (IN(k) && IN((k) + 1)) tree_barrier((unsigned*)(P.ws + WS_CTL) + (k) * 1024, wid); } while (0)
    if (IN(0)) { if (blockIdx.x == 0) { unsigned* ctl = (unsigned*)(P.ws + WS_CTL); for (int i = wid * 64 + lane_id(); i < 8 * 1024; i += NT) ctl[i] = 0u; }
        phase_prep(P, lds); }
    SEAM0();
    if (IN(1)) { if (blockIdx.x & 8) { for (int i_ = 0; i_ < 4; ++i_) __builtin_amdgcn_s_sleep(127); }
        pg8::Gemm g{(const bf16_t*)(P.ws + WS_U), (const bf16_t*)(P.ws + WS_WIN), MROWS, NPROJ, DM}; pg8::StaticOrder S; S.init(MROWS, NPROJ, (int)gridDim.x, (int)blockIdx.x);
        pg8::EpiProj E{(bf16_t*)(P.ws + WS_ATT), (bf16_t*)(P.ws + WS_Z), (bf16_t*)(P.ws + WS_MRG), (float*)(P.ws + WS_G)};
        pg8::gemm_phase<pg8::EpiProj, pg8::StaticOrder, true, true>(ring, g, S, E, wid); }
    SEAM(1);
    if (IN(2)) att::phase_compress(P, (att::lchar*)lds_raw, wid);
    SEAM(2);
    if (IN(3)) att::phase_attention(P, (att::lchar*)lds_raw, wid);
    SEAM(3);
    if (IN(4)) { pg8::Gemm g{(const bf16_t*)(P.ws + WS_Y), (const bf16_t*)(P.ws + WS_WA), MROWS, 1024, 1024}; pg8::StaticOrder S; S.init(MROWS, 1024, (int)gridDim.x, (int)blockIdx.x);
        pg8::EpiMG E{(const bf16_t*)(P.ws + WS_MRG), (bf16_t*)(P.ws + WS_MM)};
        pg8::gemm_phase<pg8::EpiMG, pg8::StaticOrder, true, true>(ring, g, S, E, wid); }
    SEAM(5);
    if (IN(6)) { pg8::Gemm g{(const bf16_t*)(P.ws + WS_MM), (const bf16_t*)(P.ws + WS_WO), MROWS, 1024, 1024}; pg8::StaticOrder S; S.init(MROWS, 1024, (int)gridDim.x, (int)blockIdx.x);
        pg8::EpiOut E{(bf16_t*)(P.ws + WS_M1), (float*)(P.ws + WS_SS)};
        pg8::gemm_phase<pg8::EpiOut, pg8::StaticOrder, true, true>(ring, g, S, E, wid); }
    SEAM(6);
    if (IN(7)) phase_final(P, wid);
#undef IN
#undef SEAM
}

extern "C" void kernel_launch(void* const* d_in, const int* in_sizes, int n_in, void* d_out, int out_size, void* d_ws, size_t ws_size, hipStream_t stream) {
    static int grid = 0;
    if (grid == 0) {
        if (n_in != 13 || out_size != MROWS * DM || ws_size < WS_END) { fprintf(stderr, "kernel_launch: unexpected shapes (n_in %d out %d ws %zu)\n", n_in, out_size, ws_size); grid = -1; return; }
        int dev = 0, cus = 0, per_cu = 0;
        (void)hipGetDevice(&dev); (void)hipDeviceGetAttribute(&cus, hipDeviceAttributeMultiprocessorCount, dev);
        if (hipFuncSetAttribute((const void*)fwd_kernel, hipFuncAttributeMaxDynamicSharedMemorySize, LDS_BYTES) != hipSuccess) { fprintf(stderr, "kernel_launch: hipFuncSetAttribute failed\n"); grid = -1; return; }
        (void)hipOccupancyMaxActiveBlocksPerMultiprocessor(&per_cu, (const void*)fwd_kernel, NT, LDS_BYTES);
        if (per_cu < 1) { fprintf(stderr, "kernel_launch: occupancy query says %d blocks per CU\n", per_cu); }
        (void)hipGetLastError();
        grid = cus;
    }
    if (grid < 0) return;
    Params p{};
    p.x = (const float*)d_in[0]; p.norm_pre = (const float*)d_in[1]; p.w_in = (const float*)d_in[2];
    p.pe_k = (const float*)d_in[3]; p.w1_k = (const float*)d_in[4]; p.w2_k = (const float*)d_in[5];
    p.pe_v = (const float*)d_in[6]; p.w1_v = (const float*)d_in[7]; p.w2_v = (const float*)d_in[8];
    p.w_a = (const float*)d_in[9]; p.w_b = (const float*)d_in[10]; p.w_o = (const float*)d_in[11]; p.norm_post = (const float*)d_in[12];
    p.out = (float*)d_out; p.ws = (unsigned char*)d_ws;
#if MK_N_LAUNCHES == 1
    p.ph_lo = 0; p.ph_hi = NPHASE;
    void* args[] = {&p};
    hipError_t e = hipLaunchCooperativeKernel((const void*)fwd_kernel, dim3(grid), dim3(NT), args, LDS_BYTES, stream);
    if (e != hipSuccess) fprintf(stderr, "cooperative launch failed: %s (grid %d)\n", hipGetErrorString(e), grid);
#else
    for (int ph = 0; ph < 8; ++ph) { p.ph_lo = ph; p.ph_hi = ph + 1; hipLaunchKernelGGL(fwd_kernel, dim3(grid), dim3(NT), LDS_BYTES, stream, p); }
#endif
}
```

```cpp
#include <hip/hip_runtime.h>
#include <hip/hip_cooperative_groups.h>
#include <cstdio>
#include <cstdint>
namespace cg = cooperative_groups;

#ifndef MK_N_LAUNCHES
#define MK_N_LAUNCHES 1
#endif

typedef unsigned short bf16_t;
#define DEVI __device__ __forceinline__

constexpr int NB = 16, SEQ = 4096, MROWS = NB * SEQ, DM = 1024;
constexpr int INCOLS = 5912, NPROJ = 6144;
constexpr float RMS_EPS = 1e-6f;
constexpr float LOG2E = 1.4426950408889634f;
constexpr float C2 = 0.125f * LOG2E;
constexpr int NT = 512;
constexpr int NPHASE = 10;

constexpr size_t MiB = 1u << 20;
constexpr size_t WS_CTL = 0;
constexpr size_t WS_WIN = 1 * MiB;
constexpr size_t WS_WA = 13 * MiB;
constexpr size_t WS_WB = 14 * MiB;
constexpr size_t WS_WO = 15 * MiB;
constexpr size_t WS_W1K = 17 * MiB;
constexpr size_t WS_W1V = 17 * MiB + 512 * 1024;
constexpr size_t WS_W2K = 21 * MiB;
constexpr size_t WS_W2V = 21 * MiB + 64 * 1024;
constexpr size_t WS_B1P = 21 * MiB + 128 * 1024;
constexpr size_t WS_KC = 18 * MiB;
constexpr size_t WS_VC = 19 * MiB;
constexpr size_t WS_KBAR = 20 * MiB;
constexpr size_t WS_G = 26 * MiB;
constexpr size_t WS_U = 32 * MiB;
constexpr size_t WS_Y = WS_U;
constexpr size_t WS_YB = WS_U + 64 * MiB;
constexpr size_t WS_SS = 22 * MiB;
constexpr size_t WS_ATT = 160 * MiB;
constexpr size_t WS_Z = 512 * MiB;
constexpr size_t WS_MRG = 640 * MiB;
constexpr size_t WS_M1 = 160 * MiB;
constexpr size_t WS_MM = 512 * MiB;
constexpr size_t WS_END = 896 * MiB;

constexpr int HC_QA = 0, HC_KCMP = 8, HC_VCMP = 10, HC_KS = 12, HC_VS = 14, HC_KW = 16, HC_VW = 18, HC_QB = 20, HC_KB = 28, HC_VB = 36;

struct Params {
    const float *x, *norm_pre, *w_in, *pe_k, *w1_k, *w2_k, *pe_v, *w1_v, *w2_v, *w_a, *w_b, *w_o, *norm_post;
    float* out; unsigned char* ws; int ph_lo, ph_hi;
};

DEVI float bf2f(bf16_t b) { return __uint_as_float((unsigned)b << 16); }
DEVI bf16_t f2bf(float f) { unsigned u = __float_as_uint(f); return (bf16_t)((u + 0x7fffu + ((u >> 16) & 1u)) >> 16); }
DEVI float wave_max(float v) {
#pragma unroll
    for (int o = 32; o; o >>= 1) v = fmaxf(v, __shfl_xor(v, o));
    return v;
}
DEVI float wave_sum(float v) {
#pragma unroll
    for (int o = 32; o; o >>= 1) v += __shfl_xor(v, o);
    return v;
}
DEVI float sigmoidf_(float x) { return 1.f / (1.f + __expf(-x)); }
DEVI float siluf_(float x) { return x / (1.f + __expf(-x)); }
#define LDS_SYNC() asm volatile("s_waitcnt lgkmcnt(0)" ::: "memory")
DEVI int lane_id() { return (int)(__builtin_amdgcn_mbcnt_hi(~0u, __builtin_amdgcn_mbcnt_lo(~0u, 0u)) & 63u); }
DEVI int lane_id_opaque() { int l = lane_id(); asm volatile("" : "+v"(l)); return l; }

DEVI int orig_col(int n) {
    if (n < 1280) return n;
    if (n < 3840) return n + 24;
    if (n < 5888) { const int j = n - 3840, t = j >> 8, w = j & 255; return 3864 + (w < 128 ? 0 : 1024) + t * 128 + (w & 127); }
    return n - 5888 + 1280;
}
DEVI void prep_transpose_item(const float* W, int N, int src_col0, int nvalid, bf16_t* WT, int K, int dst_row0, int k0, float* scr, int lane, int dst_k_off = 0) {
    { float4 v[8]; const int c4 = (lane & 7) * 4;
#pragma unroll
      for (int i = 0; i < 8; ++i) { const int kk = 8 * i + (lane >> 3); v[i] = (c4 < nvalid) ? *(const float4*)(W + (size_t)(k0 + kk) * N + src_col0 + c4) : make_float4(0.f, 0.f, 0.f, 0.f); }
#pragma unroll
      for (int i = 0; i < 8; ++i) { const int kk = 8 * i + (lane >> 3); float* q = scr + kk * 33 + c4; q[0] = v[i].x; q[1] = v[i].y; q[2] = v[i].z; q[3] = v[i].w; } }
    LDS_SYNC();
    const int c8 = lane & 7;
#pragma unroll
    for (int j = 0; j < 4; ++j) { const int n = (lane >> 3) + 8 * j; const float* p = scr + (8 * c8) * 33 + n;
        uint4 o; o.x = (unsigned)f2bf(p[0]) | ((unsigned)f2bf(p[33]) << 16); o.y = (unsigned)f2bf(p[2 * 33]) | ((unsigned)f2bf(p[3 * 33]) << 16);
        o.z = (unsigned)f2bf(p[4 * 33]) | ((unsigned)f2bf(p[5 * 33]) << 16); o.w = (unsigned)f2bf(p[6 * 33]) | ((unsigned)f2bf(p[7 * 33]) << 16);
        *(uint4*)(WT + (size_t)(dst_row0 + n) * K + dst_k_off + k0 + 8 * c8) = o; }
    LDS_SYNC();
}
DEVI void phase_prep(const Params& P, float* lds) {
    bf16_t* WinT = (bf16_t*)(P.ws + WS_WIN); bf16_t* WaT = (bf16_t*)(P.ws + WS_WA); bf16_t* WbT = (bf16_t*)(P.ws + WS_WB); bf16_t* WoT = (bf16_t*)(P.ws + WS_WO);
    {
        const int lane = threadIdx.x & 63, wv = threadIdx.x >> 6, gw = (blockIdx.x * NT + threadIdx.x) >> 6, ngw = (gridDim.x * NT) >> 6;
        float* scr = lds + wv * 4096;
        constexpr int I_IN = 16 * 192, I_AB = 8 * 32, I_O = 16 * 32, I_W1 = 32 * 4, I_W2 = 2 * 2, I_B1 = 32;
        for (int it = gw; it < I_IN + 2 * I_AB + I_O + 2 * I_W1 + 2 * I_W2 + I_B1; it += ngw) {
            int r = it;
            if (r < I_IN) { const int kb = r / 192, nb = r % 192, n0 = nb * 32; const int nvalid = n0 + 32 <= INCOLS ? 32 : (n0 < INCOLS ? INCOLS - n0 : 0);
                prep_transpose_item(P.w_in, INCOLS, nvalid ? orig_col(n0) : 0, nvalid, WinT, DM, n0, kb * 64, scr, lane); continue; }
            r -= I_IN;
            if (r < I_AB) { prep_transpose_item(P.w_a, 1024, (r % 32) * 32, 32, WaT, 1024, (r % 32) * 32, (r / 32) * 64, scr, lane); continue; }
            r -= I_AB;
            if (r < I_AB) { prep_transpose_item(P.w_b, 1024, (r % 32) * 32, 32, WaT, 1024, (r % 32) * 32, (r / 32) * 64, scr, lane, 512); continue; }
            r -= I_AB;
            if (r < I_O) { prep_transpose_item(P.w_o, 1024, (r % 32) * 32, 32, WoT, 1024, (r % 32) * 32, (r / 32) * 64, scr, lane); continue; }
            r -= I_O;
            if (r < 2 * I_W1) { const int wh = r / I_W1, q = r % I_W1;
                prep_transpose_item(wh ? P.w1_v : P.w1_k, 128, (q % 4) * 32, 32, (bf16_t*)(P.ws + (wh ? WS_W1V : WS_W1K)), 2048, (q % 4) * 32, (q / 4) * 64, scr, lane); continue; }
            r -= 2 * I_W1;
            if (r < 2 * I_W2) { const int wh = r / I_W2, q = r % I_W2;
                prep_transpose_item(wh ? P.w2_v : P.w2_k, 64, (q % 2) * 32, 32, (bf16_t*)(P.ws + (wh ? WS_W2V : WS_W2K)), 128, (q % 2) * 32, (q / 2) * 64, scr, lane); continue; }
            r -= 2 * I_W2;
            { const int wh = r >> 4, eh = (r >> 3) & 1, ch = r & 7;
              const float* pe = wh ? P.pe_v : P.pe_k; const float* w1 = wh ? P.w1_v : P.w1_k; float acc = 0.f;
              for (int kk = ch * 256; kk < ch * 256 + 256; ++kk) acc += pe[kk] * w1[(size_t)kk * 128 + eh * 64 + lane];
              ((float*)(P.ws + WS_B1P))[(wh * 8 + ch) * 128 + eh * 64 + lane] = acc; }
        }
    }
    bf16_t* U = (bf16_t*)(P.ws + WS_U);
    const int lane = threadIdx.x & 63, gw = (blockIdx.x * NT + threadIdx.x) >> 6, ngw = (gridDim.x * NT) >> 6;
    typedef float f4_t __attribute__((ext_vector_type(4)));
    typedef float f2_t __attribute__((ext_vector_type(2)));
    typedef __bf16 b2_t __attribute__((ext_vector_type(2)));
    typedef unsigned u2_t __attribute__((ext_vector_type(2)));
    constexpr int RF = 4;
    for (int r = gw * RF; r < MROWS; r += RF * ngw) {
        f4_t a[RF][4]; float ss[RF];
#pragma unroll
        for (int q = 0; q < RF; ++q) { const f4_t* xq = (const f4_t*)(P.x + (size_t)(r + q) * DM);
#pragma unroll
            for (int j = 0; j < 4; ++j) a[q][j] = __builtin_nontemporal_load(&xq[j * 64 + lane]); }
#pragma unroll
        for (int q = 0; q < RF; ++q) { float t = 0.f;
#pragma unroll
            for (int j = 0; j < 4; ++j) t += (a[q][j][0] * a[q][j][0] + a[q][j][1] * a[q][j][1]) + (a[q][j][2] * a[q][j][2] + a[q][j][3] * a[q][j][3]);
            ss[q] = wave_sum(t); }
#pragma unroll
        for (int q = 0; q < RF; ++q) { const float rs = rsqrtf(ss[q] * (1.f / DM) + RMS_EPS);
#pragma unroll
            for (int j = 0; j < 4; ++j) { const f4_t g = ((const f4_t*)P.norm_pre)[j * 64 + lane];
                const f2_t p0 = {a[q][j][0] * rs * g[0], a[q][j][1] * rs * g[1]}, p1 = {a[q][j][2] * rs * g[2], a[q][j][3] * rs * g[3]};
                u2_t w; w.x = __builtin_bit_cast(unsigned, __builtin_convertvector(p0, b2_t)); w.y = __builtin_bit_cast(unsigned, __builtin_convertvector(p1, b2_t));
                *(u2_t*)(U + (size_t)(r + q) * DM + (j * 64 + lane) * 4) = w; } }
    }
}

namespace pg8 {
#define PG8_LAS __attribute__((address_space(3)))
typedef unsigned short bf16_t;
typedef short bf16x8 __attribute__((ext_vector_type(8)));
typedef float f32x4 __attribute__((ext_vector_type(4)));
typedef unsigned u32x4 __attribute__((ext_vector_type(4)));
constexpr int BM = 256, BK = 64, HALF = 128, HTB = HALF * BK * 2  , STAGE_BYTES = 8 * HTB, NXCD = 8, WGM = 8;

__host__ __device__ __forceinline__ int lds_byte(int r, int c) { const int st = (r >> 4) * 2 + (c >> 5), rr = r & 15, cc = c & 31, ob = rr * 64 + cc * 2; return st * 1024 + (ob ^ (((ob >> 9) & 1) << 5)); }
__host__ __device__ __forceinline__ void stage_rc(int b, int& R, int& C) { const int st = b / 1024, sb = b % 1024, swz = sb ^ (((sb >> 9) & 1) << 5); R = (st >> 1) * 16 + swz / 64; C = (st & 1) * 32 + (swz % 64) / 2; }
__host__ __device__ __forceinline__ int perm32(int rho) { const int n = rho >> 4, i = rho & 15; return 8 * (i >> 2) + 4 * n + (i & 3); }

struct Unit { int pm, pn; };
struct Gemm { const bf16_t* A; const bf16_t* Bt; int M, N, K; };

struct StaticOrder {
    int nM, nN, nwg, G, c;
    __host__ __device__ void init(int M, int N, int G_, int c_) { nM = M / BM; nN = N / BM; nwg = nM * nN; G = G_; c = c_; }
    __host__ __device__ bool next(int i, Unit& u) const {
        const long L = (long)i * G + c; if (L >= nwg) return false;
        int wgid = (int)L; { const int q = nwg / NXCD, r = nwg % NXCD, xcd = wgid % NXCD, off = wgid / NXCD; wgid = (xcd < r ? xcd * (q + 1) : r * (q + 1) + (xcd - r) * q) + off; }
        const int nig = WGM * nN, gid = wgid / nig, fm = gid * WGM, gsz = (nM - fm) < WGM ? (nM - fm) : WGM;
        u.pm = fm + ((wgid % nig) % gsz); u.pn = (wgid % nig) / gsz; return true;
    }
    __device__ __forceinline__ void a_ready(const Unit&) const {}
    __device__ __forceinline__ void done(const Unit&) const {}
};

typedef float f32x2 __attribute__((ext_vector_type(2)));
typedef __bf16 bf16x2v __attribute__((ext_vector_type(2)));
__device__ __forceinline__ unsigned cvt_pk_bf16(float lo, float hi) { const f32x2 v = {lo, hi}; return __builtin_bit_cast(unsigned, __builtin_convertvector(v, bf16x2v)); }

__device__ __forceinline__ float silu_f(float x) { return x * __builtin_amdgcn_rcpf(1.f + __builtin_amdgcn_exp2f(-1.4426950408889634f * x)); }
__device__ __forceinline__ float sigm_f(float x) { return __builtin_amdgcn_rcpf(1.f + __builtin_amdgcn_exp2f(-1.4426950408889634f * x)); }
__device__ __forceinline__ float bflo(unsigned w) { return __uint_as_float(w << 16); }
__device__ __forceinline__ float bfhi(unsigned w) { return __uint_as_float(w & 0xffff0000u); }
constexpr int EM = 65536;
constexpr float EC2 = 0.125f * 1.4426950408889634f;
struct EpiProj {
    static constexpr bool PERM = true, AFTER_DRAIN = false, MIDK = false;
    bf16_t* ATT; bf16_t* Z; bf16_t* MRG; float* G;
    static constexpr int NST = 16;
    __device__ __forceinline__ bool relax(const Unit& u, int wc) const { return u.pn < 23 || wc == 0; }
    template <int KIND> __device__ __forceinline__ void tile(const f32x4 (&acc)[2][2][4][2], bf16_t* base, float sc, int row0, int cl0) const {
#pragma unroll
        for (int ai = 0; ai < 2; ++ai)
#pragma unroll
            for (int m = 0; m < 4; ++m) { const int row = row0 + ai * HALF + m * 16;
#pragma unroll
                for (int bj = 0; bj < 2; ++bj) { const int cl = cl0 + bj * HALF; f32x4 v0 = acc[ai][bj][m][0], v1 = acc[ai][bj][m][1];
                    if (KIND == 0) { v0 = v0 * sc; v1 = v1 * sc; }
                    if (KIND == 1) { for (int j = 0; j < 4; ++j) { v0[j] = silu_f(v0[j]); v1[j] = silu_f(v1[j]); } }
                    if (KIND == 2) { for (int j = 0; j < 4; ++j) { v0[j] = sigm_f(v0[j]); v1[j] = sigm_f(v1[j]); } }
                    u32x4 w; w.x = cvt_pk_bf16(v0[0], v0[1]); w.y = cvt_pk_bf16(v0[2], v0[3]); w.z = cvt_pk_bf16(v1[0], v1[1]); w.w = cvt_pk_bf16(v1[2], v1[3]);
                    bf16_t* p = (KIND == 2) ? base + (size_t)row * 2048 + cl : base + ((size_t)(cl >> 6) * EM + row) * 64 + (cl & 63);
                    *(u32x4*)p = w; } }
    }
    __device__ __forceinline__ void operator()(const f32x4 (&acc)[2][2][4][2], const Unit& u, int wr, int wc, int fr, int fq) const {
        const int pn = u.pn, row0 = u.pm * BM + wr * 64 + fr, cl0 = wc * 32 + 8 * fq; const size_t HS = (size_t)EM * 64;
        if (pn < 5) tile<0>(acc, ATT + (size_t)(pn * 4) * HS, pn < 2 ? EC2 : 1.f, row0, cl0);
        else if (pn < 7) tile<1>(acc, Z + (size_t)((pn - 5) * 4) * HS, 1.f, row0, cl0);
        else if (pn < 13) tile<0>(acc, ATT + (size_t)(20 + (pn - 7) * 4) * HS, pn < 9 ? EC2 : 1.f, row0, cl0);
        else if (pn < 15) tile<1>(acc, Z + (size_t)(8 + (pn - 13) * 4) * HS, 1.f, row0, cl0);
        else if (pn < 23) {
#pragma unroll
            for (int ai = 0; ai < 2; ++ai)
#pragma unroll
                for (int m = 0; m < 4; ++m) { const int row = row0 + ai * HALF + m * 16; const int ch = (pn - 15) * 128 + cl0;
                    f32x4 a0 = acc[ai][0][m][0], a1 = acc[ai][0][m][1], b0 = acc[ai][1][m][0], b1 = acc[ai][1][m][1];
                    for (int j = 0; j < 4; ++j) { b0[j] = sigm_f(b0[j]); b1[j] = sigm_f(b1[j]); a0[j] = sigm_f(a0[j]) * __builtin_amdgcn_rcpf(b0[j]); a1[j] = sigm_f(a1[j]) * __builtin_amdgcn_rcpf(b1[j]); }
                    u32x4 wr_, wb_; wr_.x = cvt_pk_bf16(a0[0], a0[1]); wr_.y = cvt_pk_bf16(a0[2], a0[3]); wr_.z = cvt_pk_bf16(a1[0], a1[1]); wr_.w = cvt_pk_bf16(a1[2], a1[3]);
                    wb_.x = cvt_pk_bf16(b0[0], b0[1]); wb_.y = cvt_pk_bf16(b0[2], b0[3]); wb_.z = cvt_pk_bf16(b1[0], b1[1]); wb_.w = cvt_pk_bf16(b1[2], b1[3]);
                    *(u32x4*)(MRG + (size_t)row * 2048 + ch) = wr_; *(u32x4*)(MRG + (size_t)row * 2048 + 1024 + ch) = wb_; }
        }
        else if (wc == 0 && fq < 3) {
#pragma unroll
            for (int ai = 0; ai < 2; ++ai)
#pragma unroll
                for (int m = 0; m < 4; ++m) { const int row = row0 + ai * HALF + m * 16; f32x4 v0 = acc[ai][0][m][0], v1 = acc[ai][0][m][1];
                    for (int j = 0; j < 4; ++j) { v0[j] = sigm_f(v0[j]); v1[j] = sigm_f(v1[j]); }
                    float* p = G + (size_t)row * 24 + 8 * fq; *(f32x4*)p = v0; *(f32x4*)(p + 4) = v1; }
        }
    }
};
struct EpiMG {
    static constexpr bool PERM = true, AFTER_DRAIN = false, MIDK = true;
    const bf16_t* MRG; bf16_t* MM;
    static constexpr int NST = 0;
    __device__ __forceinline__ bool relax(const Unit&, int) const { return false; }
    __device__ __forceinline__ void mid(f32x4 (&acc)[2][2][4][2], const Unit& u, int wr, int wc, int, int) const {
        const int l_ = lane_id_opaque(), fr = l_ & 15, fq = l_ >> 4;
        const int row0 = u.pm * BM + wr * 64 + fr, col0 = u.pn * BM + wc * 32 + 8 * fq;
#pragma unroll
        for (int ai = 0; ai < 2; ++ai)
#pragma unroll
            for (int m = 0; m < 4; ++m) { const int row = row0 + ai * HALF + m * 16;
#pragma unroll
                for (int bj = 0; bj < 2; ++bj) { const int col = col0 + bj * HALF; const u32x4 a = *(const u32x4*)(MRG + (size_t)row * 2048 + col);
                    f32x4& v0 = acc[ai][bj][m][0]; f32x4& v1 = acc[ai][bj][m][1];
                    v0[0] *= bflo(a.x); v0[1] *= bfhi(a.x); v0[2] *= bflo(a.y); v0[3] *= bfhi(a.y); v1[0] *= bflo(a.z); v1[1] *= bfhi(a.z); v1[2] *= bflo(a.w); v1[3] *= bfhi(a.w); }
                asm volatile("" ::: "memory"); }
    }
    __device__ __forceinline__ void operator()(const f32x4 (&acc)[2][2][4][2], const Unit& u, int wr, int wc, int fr, int fq) const {
        const int row0 = u.pm * BM + wr * 64 + fr, col0 = u.pn * BM + wc * 32 + 8 * fq;
#pragma unroll
        for (int ai = 0; ai < 2; ++ai)
#pragma unroll
            for (int m = 0; m < 4; ++m) { const int row = row0 + ai * HALF + m * 16;
#pragma unroll
                for (int bj = 0; bj < 2; ++bj) { const int col = col0 + bj * HALF; const u32x4 s = *(const u32x4*)(MRG + (size_t)row * 2048 + 1024 + col);
                    const f32x4 a0 = acc[ai][bj][m][0], a1 = acc[ai][bj][m][1];
                    u32x4 w; w.x = cvt_pk_bf16(a0[0] * bflo(s.x), a0[1] * bfhi(s.x)); w.y = cvt_pk_bf16(a0[2] * bflo(s.y), a0[3] * bfhi(s.y));
                    w.z = cvt_pk_bf16(a1[0] * bflo(s.z), a1[1] * bfhi(s.z)); w.w = cvt_pk_bf16(a1[2] * bflo(s.w), a1[3] * bfhi(s.w));
                    *(u32x4*)(MM + (size_t)row * 1024 + col) = w; } }
    }
};
struct EpiOut {
    static constexpr bool PERM = true, AFTER_DRAIN = false, MIDK = false;
    bf16_t* T; float* SS;
    static constexpr int NST = 24;
    __device__ __forceinline__ bool relax(const Unit&, int) const { return true; }
    __device__ __forceinline__ void operator()(const f32x4 (&acc)[2][2][4][2], const Unit& u, int wr, int wc, int fr, int fq) const {
        const int row0 = u.pm * BM + wr * 64 + fr, col0 = u.pn * BM + wc * 32 + 8 * fq;
#pragma unroll
        for (int ai = 0; ai < 2; ++ai)
#pragma unroll
            for (int m = 0; m < 4; ++m) { const int row = row0 + ai * HALF + m * 16; float s = 0.f;
#pragma unroll
                for (int bj = 0; bj < 2; ++bj) { const int col = col0 + bj * HALF; const f32x4 v0 = acc[ai][bj][m][0], v1 = acc[ai][bj][m][1];
                    s += (v0[0] * v0[0] + v0[1] * v0[1]) + (v0[2] * v0[2] + v0[3] * v0[3]) + (v1[0] * v1[0] + v1[1] * v1[1]) + (v1[2] * v1[2] + v1[3] * v1[3]);
                    u32x4 w; w.x = cvt_pk_bf16(v0[0], v0[1]); w.y = cvt_pk_bf16(v0[2], v0[3]); w.z = cvt_pk_bf16(v1[0], v1[1]); w.w = cvt_pk_bf16(v1[2], v1[3]);
                    *(u32x4*)(T + (size_t)row * 1024 + col) = w; }
                s += __shfl_xor(s, 16); s += __shfl_xor(s, 32);
                if (fq == 0) SS[(size_t)(u.pn * 4 + wc) * EM + row] = s; }
    }
};

template <class Epi, class Sched, bool ALIGN_EPI = false, bool SP2 = false>
__device__ __forceinline__ void gemm_phase(PG8_LAS unsigned char* lds, const Gemm g, const Sched& S, const Epi& E, const int wid) {
    const int lane = lane_id(), tid = ((wid & 7) << 6) | lane, wr = (wid >> 2) & 1, wc = wid & 3, fr = lane & 15, fq = lane >> 4;
    const int K = g.K, nt = K / BK;
    unsigned voffA[2], voffB[2];
#pragma unroll
    for (int i = 0; i < 2; ++i) { int R, C; stage_rc(tid * 16 + i * 8192, R, C); const int Rb = Epi::PERM ? ((R & ~31) + perm32(R & 31)) : R;
        voffA[i] = (unsigned)(R * K + C) * 2u; voffB[i] = (unsigned)(Rb * K + C) * 2u; }
    const size_t kstep = (size_t)(BK * 2);
    const size_t hstep = (size_t)HALF * K * 2;
    const size_t tstep = 2 * hstep;
    const unsigned ldsw = (unsigned)wid * 1024u;
    const int aoff = lds_byte(wr * 64 + fr, fq * 8), boff = lds_byte(wc * 32 + fr, fq * 8);
#define PG8_SA(b, h) (((b) * 2 + (h)) * HTB)
#define PG8_SB(b, h) ((4 + (b) * 2 + (h)) * HTB)
#define PG8_STAGE(bufoff, gbase, voff) do { _Pragma("unroll") for (int _i = 0; _i < 2; ++_i) \
        __builtin_amdgcn_global_load_lds((const unsigned*)((const char*)(gbase) + (voff)[_i]), (PG8_LAS unsigned*)(lds + (bufoff) + ldsw + _i * 8192), 16, 0, 0); } while (0)
#define PG8_LDA(dst, b, h) do { _Pragma("unroll") for (int m = 0; m < 4; ++m) _Pragma("unroll") for (int k = 0; k < 2; ++k) dst[m][k] = *(const PG8_LAS bf16x8*)(lds + PG8_SA(b, h) + aoff + m * 2048 + k * 1024); } while (0)
#define PG8_LDB(dst, b, h) do { _Pragma("unroll") for (int n = 0; n < 2; ++n) _Pragma("unroll") for (int k = 0; k < 2; ++k) dst[n][k] = *(const PG8_LAS bf16x8*)(lds + PG8_SB(b, h) + boff + n * 2048 + k * 1024); } while (0)
#define PG8_MMA(ai, bj, At, Bt) do { __builtin_amdgcn_s_setprio(1); _Pragma("unroll") for (int m = 0; m < 4; ++m) _Pragma("unroll") for (int n = 0; n < 2; ++n) _Pragma("unroll") for (int k = 0; k < 2; ++k) \
        acc[ai][bj][m][n] = __builtin_amdgcn_mfma_f32_16x16x32_bf16(Bt[n][k], At[m][k], acc[ai][bj][m][n], 0, 0, 0); __builtin_amdgcn_s_setprio(0); } while (0)
#define PG8_WAIT_V(n) asm volatile("s_waitcnt vmcnt(" #n ")" ::: "memory")
#define PG8_WAIT_L(n) asm volatile("s_waitcnt lgkmcnt(" #n ")" ::: "memory")
#define PG8_BAR __builtin_amdgcn_s_barrier()
#define PG8_SCHED __builtin_amdgcn_sched_barrier(0)
#define PG8_KT2(WV3, A11) do { \
            PG8_LDB(B0, 0, 0); PG8_LDB(B1, 0, 1); PG8_SCHED; PG8_LDA(At, 0, 0); if (A11) PG8_STAGE(PG8_SA(1, 1), a1 + hstep, voffA); \
            WV3; PG8_WAIT_L(0); PG8_BAR; PG8_MMA(0, 0, At, B0); PG8_MMA(0, 1, At, B1); PG8_BAR; PG8_SCHED; \
            PG8_LDA(At, 0, 1); PG8_STAGE(PG8_SB(0, 0), b2, voffB); PG8_STAGE(PG8_SB(0, 1), b2 + hstep, voffB); PG8_STAGE(PG8_SA(0, 0), a2, voffA); \
            WV3; PG8_WAIT_L(0); PG8_BAR; PG8_MMA(1, 0, At, B0); PG8_MMA(1, 1, At, B1); PG8_BAR; PG8_SCHED; \
            PG8_LDB(B0, 1, 0); PG8_LDB(B1, 1, 1); PG8_SCHED; PG8_LDA(At, 1, 0); PG8_STAGE(PG8_SA(0, 1), a2 + hstep, voffA); \
            WV3; PG8_WAIT_L(0); PG8_BAR; PG8_MMA(0, 0, At, B0); PG8_MMA(0, 1, At, B1); PG8_BAR; PG8_SCHED; \
            PG8_LDA(At, 1, 1); PG8_STAGE(PG8_SB(1, 0), b3, voffB); PG8_STAGE(PG8_SB(1, 1), b3 + hstep, voffB); PG8_STAGE(PG8_SA(1, 0), a3, voffA); \
            PG8_WAIT_V(8); PG8_WAIT_L(0); PG8_BAR; PG8_MMA(1, 0, At, B0); PG8_MMA(1, 1, At, B1); PG8_BAR; PG8_SCHED; } while (0)
    Unit cur, nxt; int ui = 0; bool rx = false;
    if (!S.next(0, cur)) return;
    f32x4 acc[2][2][4][2];
#pragma unroll
    for (int a = 0; a < 2; ++a)
#pragma unroll
        for (int b = 0; b < 2; ++b)
#pragma unroll
            for (int m = 0; m < 4; ++m)
#pragma unroll
                for (int n = 0; n < 2; ++n) { acc[a][b][m][n] = (f32x4){0.f, 0.f, 0.f, 0.f}; asm volatile("" : "+v"(acc[a][b][m][n])); }
    bf16x8 At[4][2], B0[2][2], B1[2][2];
    const char* cA = (const char*)g.A + (size_t)cur.pm * tstep; const char* cB = (const char*)g.Bt + (size_t)cur.pn * tstep;
    S.a_ready(cur);
    if constexpr (SP2) {
        PG8_STAGE(PG8_SB(0, 0), cB, voffB); PG8_STAGE(PG8_SB(0, 1), cB + hstep, voffB); PG8_STAGE(PG8_SA(0, 0), cA, voffA); PG8_STAGE(PG8_SA(0, 1), cA + hstep, voffA);
        if (wr == 1) PG8_BAR;
        PG8_WAIT_V(2); PG8_BAR;
        PG8_STAGE(PG8_SB(1, 0), cB + kstep, voffB); PG8_STAGE(PG8_SA(1, 0), cA + kstep, voffA); PG8_STAGE(PG8_SB(1, 1), cB + hstep + kstep, voffB);
        PG8_WAIT_V(6); PG8_BAR;
    } else {
        PG8_STAGE(PG8_SB(0, 0), cB, voffB); PG8_STAGE(PG8_SA(0, 0), cA, voffA); PG8_STAGE(PG8_SB(0, 1), cB + hstep, voffB); PG8_STAGE(PG8_SA(0, 1), cA + hstep, voffA);
        if (wr == 1) PG8_BAR;
        PG8_WAIT_V(4); PG8_BAR;
        PG8_STAGE(PG8_SB(1, 0), cB + kstep, voffB); PG8_STAGE(PG8_SA(1, 0), cA + kstep, voffA); PG8_STAGE(PG8_SB(1, 1), cB + hstep + kstep, voffB);
        PG8_WAIT_V(6); PG8_BAR;
    }
    for (;;) {
        const bool has_next = S.next(ui + 1, nxt);
        const char* nA = has_next ? (const char*)g.A + (size_t)nxt.pm * tstep : cA; const char* nB = has_next ? (const char*)g.Bt + (size_t)nxt.pn * tstep : cB;
        int t0 = 0;
        if constexpr (SP2 && Epi::NST > 0) { if (rx) {
            const char* a1 = cA + kstep; const char* a2 = cA + 2 * kstep; const char* b2 = cB + 2 * kstep; const char* a3 = a2 + kstep; const char* b3 = b2 + kstep;
            if constexpr (Epi::NST == 16) PG8_KT2(PG8_WAIT_V(24), false); else PG8_KT2(PG8_WAIT_V(32), false);
            t0 = 2; rx = false; } }
        for (int t = t0; t < nt; t += 2) {
            if constexpr (Epi::MIDK) { if (t == nt / 2) { __builtin_amdgcn_sched_barrier(0); E.mid(acc, cur, wr, wc, fr, fq); __builtin_amdgcn_sched_barrier(0); } }
            const bool last = (t == nt - 2);
            const char* a1 = cA + (size_t)(t + 1) * kstep;
            const char* a2 = last ? nA : cA + (size_t)(t + 2) * kstep; const char* b2 = last ? nB : cB + (size_t)(t + 2) * kstep;
            const char* a3 = a2 + kstep; const char* b3 = b2 + kstep;
            if (last && has_next) S.a_ready(nxt);
            if constexpr (SP2) {
            PG8_KT2(PG8_WAIT_V(8), true);
            } else {
            PG8_LDB(B0, 0, 0); PG8_SCHED; PG8_LDA(At, 0, 0); PG8_STAGE(PG8_SA(1, 1), a1 + hstep, voffA);
            PG8_WAIT_L(8); PG8_BAR; PG8_WAIT_L(0); PG8_MMA(0, 0, At, B0); PG8_BAR; PG8_SCHED;
            PG8_LDB(B1, 0, 1); PG8_STAGE(PG8_SB(0, 0), b2, voffB);
            PG8_BAR; PG8_WAIT_L(0); PG8_MMA(0, 1, At, B1); PG8_BAR;
            PG8_LDA(At, 0, 1); PG8_STAGE(PG8_SA(0, 0), a2, voffA);
            PG8_BAR; PG8_WAIT_L(0); PG8_MMA(1, 0, At, B0); PG8_BAR; PG8_SCHED;
            PG8_STAGE(PG8_SB(0, 1), b2 + hstep, voffB);
            PG8_WAIT_V(6); PG8_BAR; PG8_MMA(1, 1, At, B1); PG8_BAR;
            PG8_LDB(B0, 1, 0); PG8_SCHED; PG8_LDA(At, 1, 0); PG8_STAGE(PG8_SA(0, 1), a2 + hstep, voffA);
            PG8_WAIT_L(8); PG8_BAR; PG8_WAIT_L(0); PG8_MMA(0, 0, At, B0); PG8_BAR; PG8_SCHED;
            PG8_LDB(B1, 1, 1); PG8_STAGE(PG8_SB(1, 0), b3, voffB);
            PG8_BAR; PG8_WAIT_L(0); PG8_MMA(0, 1, At, B1); PG8_BAR;
            PG8_LDA(At, 1, 1); PG8_STAGE(PG8_SA(1, 0), a3, voffA);
            PG8_BAR; PG8_WAIT_L(0); PG8_MMA(1, 0, At, B0); PG8_BAR; PG8_SCHED;
            PG8_STAGE(PG8_SB(1, 1), b3 + hstep, voffB);
            PG8_WAIT_V(6); PG8_BAR; PG8_MMA(1, 1, At, B1); PG8_BAR;
            }
        }
        if constexpr (ALIGN_EPI) { if (wr == 0) PG8_BAR; }
        if constexpr (SP2 && !Epi::AFTER_DRAIN) { if constexpr (Epi::NST > 0) { if (has_next && E.relax(cur, wc)) { PG8_STAGE(PG8_SA(1, 1), nA + kstep + hstep, voffA); rx = true; } } }
        if constexpr (!Epi::AFTER_DRAIN) { E(acc, cur, wr, wc, fr, fq); S.done(cur); }
        if (!has_next) break;
#pragma unroll
        for (int a = 0; a < 2; ++a)
#pragma unroll
            for (int b = 0; b < 2; ++b)
#pragma unroll
                for (int m = 0; m < 4; ++m)
#pragma unroll
                    for (int n = 0; n < 2; ++n) { acc[a][b][m][n] = (f32x4){0.f, 0.f, 0.f, 0.f}; asm volatile("" : "+v"(acc[a][b][m][n])); }
        cur = nxt; cA = nA; cB = nB; ++ui;
        if constexpr (ALIGN_EPI) { if (wr == 1) PG8_BAR; }
    }
    PG8_WAIT_V(0);
    if constexpr (!ALIGN_EPI) { if (wr == 0) PG8_BAR; }
    PG8_BAR;
    if constexpr (Epi::AFTER_DRAIN) { E.fused(acc, cur, wr, wc, fr, fq, lds, wid, lane); S.done(cur); }
#undef PG8_SA
#undef PG8_SB
#undef PG8_STAGE
#undef PG8_LDA
#undef PG8_LDB
#undef PG8_MMA
#undef PG8_KT2
#undef PG8_WAIT_V
#undef PG8_WAIT_L
#undef PG8_BAR
#undef PG8_SCHED
}
}

DEVI void phase_compress(const Params& P, float* lds, const int wid) {
    const bf16_t* ATT = (const bf16_t*)(P.ws + WS_ATT);
    const int lane = lane_id_opaque(), wv = wid, gw = blockIdx.x * (NT / 64) + wid, ngw = (gridDim.x * NT) >> 6;
    float* hl = lds + wv * 128;
    for (int it = gw; it < 2 * NB * 2 * 256; it += ngw) {
        const int n = it & 255, g = (it >> 8) & 1, b = (it >> 9) & 15, which = it >> 13;
        bf16_t* OUT = (bf16_t*)(P.ws + (which ? WS_VC : WS_KC)) + ((size_t)((b * 2 + g) * 256 + n)) * 64;
        if (n == 255) { OUT[lane] = 0; continue; }
        const float* pe = which ? P.pe_v : P.pe_k; const float* w1 = which ? P.w1_v : P.w1_k; const float* w2 = which ? P.w2_v : P.w2_k;
        const bf16_t* src = ATT + ((size_t)((which ? HC_VCMP : HC_KCMP) + g) * MROWS + (size_t)b * SEQ + n * 16) * 64;
        float h0 = 0.f, h1 = 0.f;
        for (int kk = 0; kk < 2048; ++kk) { const float a = bf2f(src[kk]) + pe[kk]; h0 += a * w1[(size_t)kk * 128 + lane]; h1 += a * w1[(size_t)kk * 128 + 64 + lane]; }
        hl[lane] = siluf_(h0); hl[64 + lane] = siluf_(h1); LDS_SYNC();
        float o = 0.f;
        for (int e = 0; e < 128; ++e) o += hl[e] * w2[e * 64 + lane];
        OUT[lane] = f2bf(o); LDS_SYNC();
    }
    float* KBAR = (float*)(P.ws + WS_KBAR);
    for (int it = gw; it < NB * 8 * 16; it += ngw) {
        const int n = it & 15, h = (it >> 4) & 7, b = it >> 7;
        const bf16_t* src = ATT + ((size_t)(HC_KB + h) * MROWS + (size_t)b * SEQ + n * 256) * 64;
        float s = 0.f;
        for (int r = 0; r < 256; ++r) s += bf2f(src[r * 64 + lane]);
        KBAR[(size_t)it * 64 + lane] = s * (1.f / 256.f);
    }
}

#define NAIVE_NSA 0
#ifndef PROBE_NSA2
#define PROBE_NSA2 0
#endif
#ifndef PROBE_MOBA2
#define PROBE_MOBA2 0
#endif
#define NAIVE_MOBA 0
namespace att {
#define ALAS __attribute__((address_space(3)))
typedef short bf16x8 __attribute__((ext_vector_type(8)));
typedef short s16x4 __attribute__((ext_vector_type(4)));
typedef short v4i16_t __attribute__((ext_vector_type(4)));
typedef float f32x16 __attribute__((ext_vector_type(16)));
typedef float f32x4 __attribute__((ext_vector_type(4)));
typedef unsigned u32x4 __attribute__((ext_vector_type(4)));
typedef unsigned u32x2 __attribute__((ext_vector_type(2)));
typedef float f32x2_t __attribute__((ext_vector_type(2)));
typedef __bf16 bf16x2_t __attribute__((ext_vector_type(2)));
typedef ALAS char lchar;

constexpr float NEG = -1e30f, MFLOOR = -8192.f, THR = 6.f;
constexpr int BIG = 1000000;
constexpr int WAVE_BYTES = 11264;
constexpr int L_K = 0, L_V = 24576, L_OVT = 49152, L_KBT = 65536, L_TL = L_KBT, L_WAVE = 73728, L_WG = L_WAVE + 2688;
constexpr int W_WSF = 0, W_IMP = 512, W_MASK = 2560, W_OT = 3072;
static_assert(L_WAVE + 8 * WAVE_BYTES <= 163840, "attention LDS map");

#define ATT_MFMA(a, b, c) __builtin_amdgcn_mfma_f32_32x32x16_bf16(a, b, c, 0, 0, 0)
#define ATT_LSYNC() asm volatile("s_waitcnt lgkmcnt(0)" ::: "memory")
#define ATT_BAR() do { asm volatile("s_waitcnt lgkmcnt(0)" ::: "memory"); __builtin_amdgcn_s_barrier(); asm volatile("" ::: "memory"); } while (0)

DEVI int crow(int r, int hi) { return (r & 3) + 8 * (r >> 2) + 4 * hi; }
DEVI float max3f(float a, float b, float c) { float r; asm("v_max3_f32 %0, %1, %2, %3" : "=v"(r) : "v"(a), "v"(b), "v"(c)); return r; }
DEVI float max2f(float a, float b) { float r; asm("v_max_f32_e32 %0, %1, %2" : "=v"(r) : "v"(a), "v"(b)); return r; }
DEVI unsigned cvtpk(float lo, float hi) { f32x2_t v = {lo, hi}; bf16x2_t b = __builtin_convertvector(v, bf16x2_t); return __builtin_bit_cast(unsigned, b); }
DEVI s16x4 vtr(const lchar* p) { return __builtin_bit_cast(s16x4, __builtin_amdgcn_ds_read_tr16_b64_v4i16((ALAS v4i16_t*)p)); }
DEVI float swap_other(float x, int hi) { auto rr = __builtin_amdgcn_permlane32_swap(__float_as_uint(x), __float_as_uint(x), false, false); return __uint_as_float(hi ? rr[0] : rr[1]); }
DEVI float swap_max(float x) { auto rr = __builtin_amdgcn_permlane32_swap(__float_as_uint(x), __float_as_uint(x), false, false); return fmaxf(__uint_as_float(rr[0]), __uint_as_float(rr[1])); }
DEVI float swap_sum(float x) { auto rr = __builtin_amdgcn_permlane32_swap(__float_as_uint(x), __float_as_uint(x), false, false); return __uint_as_float(rr[0]) + __uint_as_float(rr[1]); }

struct Stage { u32x4 k, v; };
DEVI void stage_load(Stage& s, const bf16_t* Kblk, const bf16_t* Vblk, int wid, int lane) {
    s.k = *(const u32x4*)(Kblk + lane * 64 + wid * 8);
    s.v = *(const u32x4*)(Vblk + (16 * (wid & 3) + (lane >> 2)) * 64 + (wid >> 2) * 32 + (lane & 3) * 8);
}
DEVI void stage_write(const Stage& s, lchar* Kb, lchar* Vb, int wid, int lane) {
    *(ALAS u32x4*)(Kb + wid * 1024 + lane * 16) = s.k;
    *(ALAS u32x4*)(Vb + wid * 1024 + lane * 16) = s.v;
}

template <int NO, bool EMASK>
DEVI void flash_block(const lchar* Kb, const lchar* Vb, const lchar* OVb, const bf16x8 (&qr)[4], f32x16 (&o)[NO], float& m, float& l, const bool first,
                      const float cbase, const float kslope, const int lim_lo, const int lim_hi, ALAS float* wsf, const int lane) {
    const int r32 = lane & 31, hi = lane >> 5;
    const float cb = first ? cbase : cbase - m;
    f32x16 p0, p1;
#pragma unroll
    for (int r = 0; r < 16; ++r) { const float lit = (float)((r & 3) + 8 * (r >> 2)); p0[r] = __builtin_fmaf(kslope, lit, cb); p1[r] = __builtin_fmaf(kslope, lit + 32.f, cb); }
    const lchar* kb = Kb + hi * 1024 + r32 * 16;
    __builtin_amdgcn_s_setprio(1);
#pragma unroll
    for (int d0 = 0; d0 < 4; ++d0) {
        const bf16x8 b0 = *(const ALAS bf16x8*)(kb + d0 * 2048), b1 = *(const ALAS bf16x8*)(kb + d0 * 2048 + 512);
        p0 = ATT_MFMA(b0, qr[d0], p0); p1 = ATT_MFMA(b1, qr[d0], p1);
        if (NO > 2 && (d0 & 1)) __builtin_amdgcn_sched_barrier(0);
    }
    __builtin_amdgcn_s_setprio(0);
    const int va = ((lane >> 4) & 1) * 32 + (lane & 3) * 8 + (4 * hi + ((lane & 15) >> 2)) * 64;
    bf16x8 vfr[1][4];
    if (NO == 2) {
#pragma unroll
        for (int d = 0; d < 1; ++d) {
            const lchar* vb = Vb + d * 4096 + va;
#pragma unroll
            for (int ks = 0; ks < 4; ++ks) { const s16x4 lo4 = vtr(vb + ks * 1024), hi4 = vtr(vb + ks * 1024 + 512);
                vfr[d][ks] = (bf16x8){lo4[0], lo4[1], lo4[2], lo4[3], hi4[0], hi4[1], hi4[2], hi4[3]}; }
        }
        __builtin_amdgcn_sched_barrier(0);
    }
    if (EMASK) {
        const int lo_ = lim_lo - 4 * hi, hi_ = lim_hi - 4 * hi;
#pragma unroll
        for (int r = 0; r < 16; ++r) { const int lit = (r & 3) + 8 * (r >> 2);
            p0[r] = (lit >= lo_ && lit <= hi_) ? p0[r] : NEG; p1[r] = (lit + 32 >= lo_ && lit + 32 <= hi_) ? p1[r] : NEG; }
    }
    float rm, rm2;
    { rm = max3f(p0[0], p0[1], p1[0]); rm2 = max3f(p0[2], p0[3], p1[1]); rm = max3f(rm, p1[2], p1[3]);
#pragma unroll
      for (int r = 4; r < 16; r += 4) { rm = max3f(rm, p0[r], p0[r + 1]); rm2 = max3f(rm2, p0[r + 2], p0[r + 3]); rm = max3f(rm, p1[r], p1[r + 1]); rm2 = max3f(rm2, p1[r + 2], p1[r + 3]); }
      rm = max2f(rm, rm2); }
    { auto rr = __builtin_amdgcn_permlane32_swap(__float_as_uint(rm), __float_as_uint(rm), false, false); rm = max2f(__uint_as_float(rr[0]), __uint_as_float(rr[1])); }
    float dl = 0.f; bool sub;
    if (first) { m = max2f(rm, MFLOOR); dl = m; sub = true; }
    else {
        sub = __any(rm > THR);
        if (sub) {
            dl = max2f(rm, 0.f); m += dl;
            const float alpha = __builtin_amdgcn_exp2f(-dl); l *= alpha;
            wsf[r32] = alpha; ATT_LSYNC();
#pragma unroll
            for (int r = 0; r < 16; ++r) { const float a = wsf[crow(r, hi)];
#pragma unroll
                for (int d = 0; d < NO; ++d) o[d][r] *= a; }
            ATT_LSYNC();
        }
    }
    if (sub) {
#pragma unroll
        for (int r = 0; r < 16; ++r) { p0[r] -= dl; p1[r] -= dl; }
    }
    float s = 0.f;
#pragma unroll
    for (int r = 0; r < 16; ++r) { p0[r] = __builtin_amdgcn_exp2f(p0[r]); p1[r] = __builtin_amdgcn_exp2f(p1[r]); s += p0[r] + p1[r]; }
    l += s;
    u32x4 pw[4];
    pw[0] = (u32x4){cvtpk(p0[0], p0[1]), cvtpk(p0[2], p0[3]), cvtpk(p0[4], p0[5]), cvtpk(p0[6], p0[7])};
    pw[1] = (u32x4){cvtpk(p0[8], p0[9]), cvtpk(p0[10], p0[11]), cvtpk(p0[12], p0[13]), cvtpk(p0[14], p0[15])};
    pw[2] = (u32x4){cvtpk(p1[0], p1[1]), cvtpk(p1[2], p1[3]), cvtpk(p1[4], p1[5]), cvtpk(p1[6], p1[7])};
    pw[3] = (u32x4){cvtpk(p1[8], p1[9]), cvtpk(p1[10], p1[11]), cvtpk(p1[12], p1[13]), cvtpk(p1[14], p1[15])};
    if (NO == 2) {
        bf16x8 vf1[4];
#pragma unroll
        for (int ks = 0; ks < 4; ++ks) { const lchar* vb = Vb + 4096 + va; const s16x4 lo4 = vtr(vb + ks * 1024), hi4 = vtr(vb + ks * 1024 + 512);
            vf1[ks] = (bf16x8){lo4[0], lo4[1], lo4[2], lo4[3], hi4[0], hi4[1], hi4[2], hi4[3]}; }
        __builtin_amdgcn_s_setprio(1);
#pragma unroll
        for (int ks = 0; ks < 4; ++ks) o[0] = ATT_MFMA(__builtin_bit_cast(bf16x8, pw[ks]), vfr[0][ks], o[0]);
#pragma unroll
        for (int ks = 0; ks < 4; ++ks) o[1] = ATT_MFMA(__builtin_bit_cast(bf16x8, pw[ks]), vf1[ks], o[1]);
        __builtin_amdgcn_s_setprio(0);
    } else {
#pragma unroll
        for (int d = 0; d < NO; ++d) {
            const lchar* vb = (d < 2 ? Vb + d * 4096 : OVb + (d - 2) * 4096) + va;
#pragma unroll
            for (int ks = 0; ks < 4; ++ks) {
                const s16x4 lo4 = vtr(vb + ks * 1024), hi4 = vtr(vb + ks * 1024 + 512);
                const bf16x8 vf = {lo4[0], lo4[1], lo4[2], lo4[3], hi4[0], hi4[1], hi4[2], hi4[3]};
                o[d] = ATT_MFMA(__builtin_bit_cast(bf16x8, pw[ks]), vf, o[d]);
            }
            __builtin_amdgcn_sched_barrier(0);
        }
    }
}


DEVI void glds16s(const void* sbase, unsigned voff, unsigned lds_dst) { unsigned keep;
    asm volatile("s_mov_b32 %0, m0\n\ts_mov_b32 m0, %3\n\ts_nop 0\n\tglobal_load_lds_dwordx4 %1, %2\n\ts_mov_b32 m0, %0" : "=&s"(keep) : "v"(voff), "s"(sbase), "s"(lds_dst) : "memory"); }
DEVI void glds16(const void* gsrc, unsigned lds_dst) { unsigned keep;
    asm volatile("s_mov_b32 %0, m0\n\ts_mov_b32 m0, %2\n\ts_nop 0\n\tglobal_load_lds_dwordx4 %1, off\n\ts_mov_b32 m0, %0" : "=&s"(keep) : "v"(gsrc), "s"(lds_dst) : "memory"); }
#define ATT_WAIT_BAR(N) asm volatile("s_waitcnt vmcnt(" #N ") lgkmcnt(0)\n\ts_barrier" ::: "memory")
#define ATT_WAIT_BAR_N(n) do { if ((n) >= 3) ATT_WAIT_BAR(3); else if ((n) == 2) ATT_WAIT_BAR(2); else if ((n) == 1) ATT_WAIT_BAR(1); else ATT_WAIT_BAR(0); } while (0)
DEVI void kload8(bf16x8 (&kf)[8], const lchar* kp) {
#pragma unroll
    for (int d0 = 0; d0 < 4; ++d0) { kf[2 * d0] = *(const ALAS bf16x8*)(kp + d0 * 2048); kf[2 * d0 + 1] = *(const ALAS bf16x8*)(kp + d0 * 2048 + 512); }
}
template <bool EMASK>
DEVI void qk_softmax(const bf16x8 (&kf)[8], const bf16x8 (&qr)[4], f32x16 (&o)[2], float& m, float& l, const bool first,
                     const float cbase, const float kslope, const int lim_lo, const int lim_hi, ALAS float* wsf, const int lane, u32x4 (&pw)[4]) {
    const int r32 = lane & 31, hi = lane >> 5;
    const float cb = first ? cbase : cbase - m;
    f32x16 p0, p1;
#pragma unroll
    for (int r = 0; r < 16; ++r) { const float lit = (float)((r & 3) + 8 * (r >> 2)); p0[r] = __builtin_fmaf(kslope, lit, cb); p1[r] = __builtin_fmaf(kslope, lit + 32.f, cb); }
    __builtin_amdgcn_s_setprio(1);
#pragma unroll
    for (int d0 = 0; d0 < 4; ++d0) { p0 = ATT_MFMA(kf[2 * d0], qr[d0], p0); p1 = ATT_MFMA(kf[2 * d0 + 1], qr[d0], p1); }
    __builtin_amdgcn_s_setprio(0);
    if (EMASK) {
        const int lo_ = lim_lo - 4 * hi, hi_ = lim_hi - 4 * hi;
#pragma unroll
        for (int r = 0; r < 16; ++r) { const int lit = (r & 3) + 8 * (r >> 2);
            p0[r] = (lit >= lo_ && lit <= hi_) ? p0[r] : NEG; p1[r] = (lit + 32 >= lo_ && lit + 32 <= hi_) ? p1[r] : NEG; }
    }
    float rm, rm2;
    { rm = max3f(p0[0], p0[1], p1[0]); rm2 = max3f(p0[2], p0[3], p1[1]); rm = max3f(rm, p1[2], p1[3]);
#pragma unroll
      for (int r = 4; r < 16; r += 4) { rm = max3f(rm, p0[r], p0[r + 1]); rm2 = max3f(rm2, p0[r + 2], p0[r + 3]); rm = max3f(rm, p1[r], p1[r + 1]); rm2 = max3f(rm2, p1[r + 2], p1[r + 3]); }
      rm = max2f(rm, rm2); }
    { auto rr = __builtin_amdgcn_permlane32_swap(__float_as_uint(rm), __float_as_uint(rm), false, false); rm = max2f(__uint_as_float(rr[0]), __uint_as_float(rr[1])); }
    float dl = 0.f; bool sub;
    if (first) { m = max2f(rm, MFLOOR); dl = m; sub = true; }
    else {
        sub = __any(rm > THR);
        if (sub) {
            dl = max2f(rm, 0.f); m += dl;
            const float alpha = __builtin_amdgcn_exp2f(-dl); l *= alpha;
            wsf[r32] = alpha; ATT_LSYNC();
#pragma unroll
            for (int r = 0; r < 16; ++r) { const float a = wsf[crow(r, hi)]; o[0][r] *= a; o[1][r] *= a; }
            ATT_LSYNC();
        }
    }
    if (sub) {
#pragma unroll
        for (int r = 0; r < 16; ++r) { p0[r] -= dl; p1[r] -= dl; }
    }
    float s = 0.f;
#pragma unroll
    for (int r = 0; r < 16; ++r) { p0[r] = __builtin_amdgcn_exp2f(p0[r]); p1[r] = __builtin_amdgcn_exp2f(p1[r]); s += p0[r] + p1[r]; }
    l += s;
    pw[0] = (u32x4){cvtpk(p0[0], p0[1]), cvtpk(p0[2], p0[3]), cvtpk(p0[4], p0[5]), cvtpk(p0[6], p0[7])};
    pw[1] = (u32x4){cvtpk(p0[8], p0[9]), cvtpk(p0[10], p0[11]), cvtpk(p0[12], p0[13]), cvtpk(p0[14], p0[15])};
    pw[2] = (u32x4){cvtpk(p1[0], p1[1]), cvtpk(p1[2], p1[3]), cvtpk(p1[4], p1[5]), cvtpk(p1[6], p1[7])};
    pw[3] = (u32x4){cvtpk(p1[8], p1[9]), cvtpk(p1[10], p1[11]), cvtpk(p1[12], p1[13]), cvtpk(p1[14], p1[15])};
}
DEVI void pv2(const u32x4 (&pw)[4], const lchar* Vb, f32x16 (&o)[2], const int lane) {
    const int hi = lane >> 5;
    const int va = ((lane >> 4) & 1) * 32 + (lane & 3) * 8 + (4 * hi + ((lane & 15) >> 2)) * 64;
    bf16x8 vf[2][4];
#pragma unroll
    for (int d = 0; d < 2; ++d) { const lchar* vb = Vb + d * 4096 + va;
#pragma unroll
        for (int ks = 0; ks < 4; ++ks) { const s16x4 lo4 = vtr(vb + ks * 1024), hi4 = vtr(vb + ks * 1024 + 512);
            vf[d][ks] = (bf16x8){lo4[0], lo4[1], lo4[2], lo4[3], hi4[0], hi4[1], hi4[2], hi4[3]}; } }
    __builtin_amdgcn_s_setprio(1);
#pragma unroll
    for (int d = 0; d < 2; ++d)
#pragma unroll
        for (int ks = 0; ks < 4; ++ks) o[d] = ATT_MFMA(__builtin_bit_cast(bf16x8, pw[ks]), vf[d][ks], o[d]);
    __builtin_amdgcn_s_setprio(0);
}


#define SBAR() __builtin_amdgcn_sched_barrier(0)
#define PIN(x) asm volatile("" : "+v"(x))
#define fmak(a, K, c) ([&]() { float r_; asm("v_fmamk_f32 %0, %1, %3, %2" : "=v"(r_) : "v"(a), "v"(c), "n"(__builtin_bit_cast(unsigned, (float)(K)))); return r_; }())
DEVI unsigned cvtpk_a(float lo, float hi) { unsigned r; asm("v_cvt_pk_bf16_f32 %0, %1, %2" : "=v"(r) : "v"(lo), "v"(hi)); return r; }
DEVI void kload2(bf16x8 (&kf)[8], const lchar* kp, int d0) { kf[2 * d0] = *(const ALAS bf16x8*)(kp + d0 * 2048); kf[2 * d0 + 1] = *(const ALAS bf16x8*)(kp + d0 * 2048 + 512); }
DEVI float rowmax32(const f32x16& p0, const f32x16& p1) {
    float rm, rm2;
    asm("v_max3_f32 %0, %1, %2, %3\n\tv_max3_f32 %0, %0, %4, %5\n\tv_max3_f32 %0, %0, %6, %7\n\tv_max3_f32 %0, %0, %8, %9\n\tv_max3_f32 %0, %0, %10, %11\n\tv_max3_f32 %0, %0, %12, %13\n\tv_max3_f32 %0, %0, %14, %15\n\tv_max3_f32 %0, %0, %16, %17"
        : "=&v"(rm) : "v"(p0[0]), "v"(p0[1]), "v"(p1[0]), "v"(p1[2]), "v"(p1[3]), "v"(p0[4]), "v"(p0[5]), "v"(p1[4]), "v"(p1[5]), "v"(p0[8]), "v"(p0[9]), "v"(p1[8]), "v"(p1[9]), "v"(p0[12]), "v"(p0[13]), "v"(p1[12]), "v"(p1[13]));
    asm("v_max3_f32 %0, %1, %2, %3\n\tv_max3_f32 %0, %0, %4, %5\n\tv_max3_f32 %0, %0, %6, %7\n\tv_max3_f32 %0, %0, %8, %9\n\tv_max3_f32 %0, %0, %10, %11\n\tv_max3_f32 %0, %0, %12, %13\n\tv_max3_f32 %0, %0, %14, %15"
        : "=&v"(rm2) : "v"(p0[2]), "v"(p0[3]), "v"(p1[1]), "v"(p0[6]), "v"(p0[7]), "v"(p1[6]), "v"(p1[7]), "v"(p0[10]), "v"(p0[11]), "v"(p1[10]), "v"(p1[11]), "v"(p0[14]), "v"(p0[15]), "v"(p1[14]), "v"(p1[15]));
    rm = max2f(rm, rm2);
    auto rr = __builtin_amdgcn_permlane32_swap(__float_as_uint(rm), __float_as_uint(rm), false, false); return max2f(__uint_as_float(rr[0]), __uint_as_float(rr[1])); }
DEVI void emask_apply(f32x16& p0, f32x16& p1, const int lim_lo, const int lim_hi, const int hi) {
    const int lo_ = lim_lo - 4 * hi, hi_ = lim_hi - 4 * hi;
#pragma unroll
    for (int r = 0; r < 16; ++r) { const int lit = (r & 3) + 8 * (r >> 2);
        p0[r] = (lit >= lo_ && lit <= hi_) ? p0[r] : NEG; p1[r] = (lit + 32 >= lo_ && lit + 32 <= hi_) ? p1[r] : NEG; } }
template <class Seq>
DEVI void pipe_pass(lchar* L, const Seq& seq, const bf16_t* Kb, const bf16_t* Vb, const bf16x8 (&qr)[4], f32x16 (&o)[2], float& m_out, float& l_out,
                    const float slope2, const int tpos, ALAS float* wsf, const int wid, const int lane) {
    const int r32 = lane & 31, hi = lane >> 5, NT = seq.NT;
    const unsigned kdst = (unsigned)(uintptr_t)(L + L_K) + (unsigned)wid * 1024u, vdst = (unsigned)(uintptr_t)(L + L_V) + (unsigned)wid * 1024u;
    const unsigned koff = (unsigned)(lane * 64 + wid * 8) * 2u, voff = (unsigned)((16 * (wid & 3) + (lane >> 2)) * 64 + (wid >> 2) * 32 + (lane & 3) * 8) * 2u;
#define PP_DMA_K(d, slot) glds16s(Kb + (size_t)__builtin_amdgcn_readfirstlane(seq.krow(d)) * 64, koff, (unsigned)__builtin_amdgcn_readfirstlane((int)(kdst + (unsigned)(slot))))
#define PP_DMA_V(d, slot) glds16s(Vb + (size_t)__builtin_amdgcn_readfirstlane(seq.krow(d)) * 64, voff, (unsigned)__builtin_amdgcn_readfirstlane((int)(vdst + (unsigned)(slot))))
    const lchar* vp0 = L + L_V + ((lane >> 4) & 1) * 32 + (lane & 3) * 8 + (4 * hi + ((lane & 15) >> 2)) * 64;
    const lchar* kp0 = L + L_K + hi * 1024 + r32 * 16;
    const float posf = (float)(-tpos);
    const unsigned kb16_ = (unsigned)f2bf((float)r32), kb16b_ = (unsigned)f2bf((float)(r32 + 32));
    const unsigned ka0 = hi ? 0u : kb16_ * 0x10001u, ka1 = hi ? 0u : kb16b_ * 0x10001u, kc1 = hi ? 0u : 0x3F803F80u, kc2 = hi ? 0u : 0x00003F80u;
    unsigned qw0, qw1 = 0u, qw2 = 0u;
    { const unsigned h_ = (unsigned)f2bf(slope2); const float rem_ = slope2 - bf2f((bf16_t)h_); qw0 = h_ | ((unsigned)f2bf(rem_) << 16); }
#define PP_CB(d) (seq.vis(d) ? slope2 * ((float)seq.krow(d) + posf) : NEG)
#define PP_QB(cb_) do { const float c0_ = (cb_); const unsigned h1_ = __float_as_uint(c0_) & 0xffff0000u; const float r1_ = c0_ - __uint_as_float(h1_); \
        const unsigned h2_ = __float_as_uint(r1_) & 0xffff0000u; const float r2_ = r1_ - __uint_as_float(h2_); qw1 = __builtin_amdgcn_perm(h2_, h1_, 0x07060302u); qw2 = __float_as_uint(r2_) >> 16; } while (0)
#define PP_BIAS(C0, C1) do { u32x4 ka_ = {ka0, kc1, kc2, 0u}, kb_ = {ka1, kc1, kc2, 0u}; const u32x4 qb_ = {qw0, qw1, qw2, 0u}; \
        C0 = ATT_MFMA(__builtin_bit_cast(bf16x8, ka_), __builtin_bit_cast(bf16x8, qb_), C0); C1 = ATT_MFMA(__builtin_bit_cast(bf16x8, kb_), __builtin_bit_cast(bf16x8, qb_), C1); } while (0)
#define PP_BIAS0(C0, C1) do { u32x4 ka_ = {ka0, kc1, kc2, 0u}, kb_ = {ka1, kc1, kc2, 0u}; const u32x4 qb_ = {qw0, qw1, qw2, 0u}; \
        C0 = ATT_MFMA(__builtin_bit_cast(bf16x8, ka_), __builtin_bit_cast(bf16x8, qb_), Z16); C1 = ATT_MFMA(__builtin_bit_cast(bf16x8, kb_), __builtin_bit_cast(bf16x8, qb_), Z16); } while (0)
    const f32x16 Z16 = {0.f, 0.f, 0.f, 0.f, 0.f, 0.f, 0.f, 0.f, 0.f, 0.f, 0.f, 0.f, 0.f, 0.f, 0.f, 0.f};
#define PP_LIT(r) ((float)(((r) & 3) + 8 * ((r) >> 2)))
    float mhat = 0.f, l_reg = 0.f; bool resc = false;
    f32x16 pA0, pA1, pB0, pB1; bf16x8 kf[8]; s16x4 vlo[8], vhi[8]; u32x4 pw0, pw1, pw2, pw3;
    int sl_prev = 0, sl_cur = 0, sl_next = 8192;
#define PP_ROT() do { sl_prev = sl_cur; sl_cur = sl_next; sl_next = (sl_next == 16384) ? 0 : sl_next + 8192; } while (0)
    int d_0 = seq.desc(0), d_1 = seq.desc(1), d_2 = seq.desc(2), d_3 = seq.desc(3);
    asm volatile("s_waitcnt vmcnt(0)" ::: "memory");
    PP_DMA_K(d_0, 0); PP_DMA_V(d_0, 0); if (NT > 1) PP_DMA_K(d_1, 8192); if (NT > 2) PP_DMA_K(d_2, 16384);
    PP_QB(PP_CB(d_0));
    ATT_WAIT_BAR_N(1 + (NT > 1 ? 1 : 0) + (NT > 2 ? 1 : 0));
#pragma unroll
    for (int d0 = 0; d0 < 4; ++d0) kload2(kf, kp0, d0);
#pragma unroll
    for (int d0 = 0; d0 < 4; ++d0) { pA0 = ATT_MFMA(kf[2 * d0], qr[d0], d0 ? pA0 : Z16); pA1 = ATT_MFMA(kf[2 * d0 + 1], qr[d0], d0 ? pA1 : Z16); }
    PP_BIAS(pA0, pA1);
    if (seq.emask(d_0)) emask_apply(pA0, pA1, seq.lo(d_0), seq.hi_(d_0), hi);
    { mhat = max2f(rowmax32(pA0, pA1), MFLOOR);
#pragma unroll
      for (int r = 0; r < 16; ++r) { pA0[r] = __builtin_amdgcn_exp2f(pA0[r] - mhat); pA1[r] = __builtin_amdgcn_exp2f(pA1[r] - mhat); } }
    ATT_WAIT_BAR(0);
    if (NT > 3) PP_DMA_K(d_3, 0);
    if (NT > 1) { PP_DMA_V(d_1, 8192); PP_ROT();
#pragma unroll
        for (int d0 = 0; d0 < 4; ++d0) kload2(kf, kp0 + sl_cur, d0);
        PP_QB(PP_CB(d_1) - mhat); }
    ATT_WAIT_BAR_N((NT > 3 ? 1 : 0) + (NT > 1 ? 1 : 0));
    d_0 = d_1; d_1 = d_2; d_2 = d_3; d_3 = seq.desc(4);
#define PP_PKW(P, i) cvtpk(P[i], P[i + 1])
#define PP_PAF(k) __builtin_bit_cast(bf16x8, pw##k)
#define PP_VFR(i) (bf16x8){vlo[i][0], vlo[i][1], vlo[i][2], vlo[i][3], vhi[i][0], vhi[i][1], vhi[i][2], vhi[i][3]}
#define PP_VRD(i) do { vlo[i] = vtr(vp_ + (((i) >> 2) * 4096 + ((i) & 3) * 1024)); vhi[i] = vtr(vp_ + (((i) >> 2) * 4096 + ((i) & 3) * 1024 + 512)); } while (0)
#define PP_KRD(d0) do { kload2(kf, kp0 + sl_next, d0); SBAR(); } while (0)
#define PP_GAPA(MF, a0, a1, a2, a3, W0, W1, PW) do { MF; sacc += a0; sacc += a1; sacc += a2; sacc += a3; W0; W1; PIN(PW); PIN(sacc); SBAR(); } while (0)
#define PP_GAPA2(MF, a0, a1, W0, W1, PW) do { MF; sacc += a0; sacc += a1; W0; W1; PIN(PW); PIN(sacc); SBAR(); } while (0)
#define PP_GAPB(MF, X, Y, i, off) do { MF; X[i] = __builtin_amdgcn_exp2f(X[i]); X[i + 1] = __builtin_amdgcn_exp2f(X[i + 1]); X[i + 2] = __builtin_amdgcn_exp2f(X[i + 2]); X[i + 3] = __builtin_amdgcn_exp2f(X[i + 3]); PIN(X); SBAR(); } while (0)
#define PP_STEP(C0, C1, P0, P1, t) do { SBAR(); \
    PP_BIAS0(C0, C1); float cb1_ = PP_CB(d_1); PIN(cb1_); SBAR();                                \
    const lchar* vp_ = vp0 + sl_prev; \
    PP_VRD(0); SBAR(); float sacc = P0[0] + P0[1]; \
                       PP_GAPA(C0 = ATT_MFMA(kf[0], qr[0], C0), P0[2], P0[3], P0[4], P0[5],     pw0[0] = PP_PKW(P0, 0),  pw0[1] = PP_PKW(P0, 2),  pw0); \
    PP_VRD(4); SBAR(); PP_GAPA(C1 = ATT_MFMA(kf[1], qr[0], C1), P0[6], P0[7], P0[8], P0[9],     pw0[2] = PP_PKW(P0, 4),  pw0[3] = PP_PKW(P0, 6),  pw0); \
    PP_VRD(1); SBAR(); PP_GAPA(C0 = ATT_MFMA(kf[2], qr[1], C0), P0[10], P0[11], P0[12], P0[13], pw1[0] = PP_PKW(P0, 8),  pw1[1] = PP_PKW(P0, 10), pw1); \
    PP_VRD(5); SBAR(); PP_GAPA(C1 = ATT_MFMA(kf[3], qr[1], C1), P0[14], P0[15], P1[0], P1[1],   pw1[2] = PP_PKW(P0, 12), pw1[3] = PP_PKW(P0, 14), pw1); \
    PP_VRD(2); SBAR(); PP_GAPA(C0 = ATT_MFMA(kf[4], qr[2], C0), P1[2], P1[3], P1[4], P1[5],     pw2[0] = PP_PKW(P1, 0),  pw2[1] = PP_PKW(P1, 2),  pw2); \
    PP_VRD(6); SBAR(); PP_GAPA(C1 = ATT_MFMA(kf[5], qr[2], C1), P1[6], P1[7], P1[8], P1[9],     pw2[2] = PP_PKW(P1, 4),  pw2[3] = PP_PKW(P1, 6),  pw2); \
    PP_VRD(3); SBAR(); PP_GAPA(C0 = ATT_MFMA(kf[6], qr[3], C0), P1[10], P1[11], P1[12], P1[13], pw3[0] = PP_PKW(P1, 8),  pw3[1] = PP_PKW(P1, 10), pw3); \
    PP_VRD(7); SBAR(); PP_GAPA2(C1 = ATT_MFMA(kf[7], qr[3], C1), P1[14], P1[15],                pw3[2] = PP_PKW(P1, 12), pw3[3] = PP_PKW(P1, 14), pw3); \
    l_reg += sacc; \
    const bool ik_ = (t) + 3 < NT, iv_ = (t) + 1 < NT; \
    if (ik_) PP_DMA_K(d_3, sl_cur); if (iv_) PP_DMA_V(d_1, sl_next);                                     \
    if (seq.emask(d_0)) emask_apply(C0, C1, seq.lo(d_0), seq.hi_(d_0), hi); \
    { const float rm = rowmax32(C0, C1); resc = false;                                                   \
      if (__builtin_expect(__any(rm > THR), 0)) { const float dl = max2f(rm, 0.f); mhat += dl;           \
          const float f = __builtin_amdgcn_exp2f(-dl); l_reg *= f; if (hi == 0) wsf[r32] = f; resc = true; \
          _Pragma("unroll") for (int r = 0; r < 16; ++r) { C0[r] -= dl; C1[r] -= dl; } } } \
    PP_QB(cb1_ - mhat); const int d_4 = seq.desc((t) + 4); SBAR(); \
    PP_GAPB(o[0] = ATT_MFMA(PP_PAF(0), PP_VFR(0), o[0]), C0, P0, 0, 0.f);               PP_GAPB(o[1] = ATT_MFMA(PP_PAF(0), PP_VFR(4), o[1]), C0, P0, 4, 0.f); \
    PP_KRD(0); PP_GAPB(o[0] = ATT_MFMA(PP_PAF(1), PP_VFR(1), o[0]), C0, P0, 8, 0.f);    PP_KRD(1); PP_GAPB(o[1] = ATT_MFMA(PP_PAF(1), PP_VFR(5), o[1]), C0, P0, 12, 0.f); \
    PP_KRD(2); PP_GAPB(o[0] = ATT_MFMA(PP_PAF(2), PP_VFR(2), o[0]), C1, P1, 0, 32.f);   PP_KRD(3); PP_GAPB(o[1] = ATT_MFMA(PP_PAF(2), PP_VFR(6), o[1]), C1, P1, 4, 32.f); \
    PP_GAPB(o[0] = ATT_MFMA(PP_PAF(3), PP_VFR(3), o[0]), C1, P1, 8, 32.f);              PP_GAPB(o[1] = ATT_MFMA(PP_PAF(3), PP_VFR(7), o[1]), C1, P1, 12, 32.f); \
    ATT_WAIT_BAR_N((ik_ ? 1 : 0) + (iv_ ? 1 : 0));                                                        \
    if (resc) { _Pragma("unroll") for (int d_ = 0; d_ < 2; ++d_) _Pragma("unroll") for (int r = 0; r < 16; ++r) o[d_][r] *= wsf[crow(r, hi)]; } \
    PP_ROT(); d_0 = d_1; d_1 = d_2; d_2 = d_3; d_3 = d_4; \
    } while (0)
#define PP_DRAIN(P0, P1) do { float sacc = P0[0] + P0[1]; \
      _Pragma("unroll") for (int r = 2; r < 16; ++r) sacc += P0[r]; \
      _Pragma("unroll") for (int r = 0; r < 16; ++r) sacc += P1[r]; \
      l_reg += sacc; \
      pw0 = (u32x4){PP_PKW(P0, 0), PP_PKW(P0, 2), PP_PKW(P0, 4), PP_PKW(P0, 6)}; pw1 = (u32x4){PP_PKW(P0, 8), PP_PKW(P0, 10), PP_PKW(P0, 12), PP_PKW(P0, 14)}; \
      pw2 = (u32x4){PP_PKW(P1, 0), PP_PKW(P1, 2), PP_PKW(P1, 4), PP_PKW(P1, 6)}; pw3 = (u32x4){PP_PKW(P1, 8), PP_PKW(P1, 10), PP_PKW(P1, 12), PP_PKW(P1, 14)}; \
      const lchar* vp_ = vp0 + sl_prev; _Pragma("unroll") for (int i = 0; i < 8; ++i) PP_VRD(i); \
      o[0] = ATT_MFMA(PP_PAF(0), PP_VFR(0), o[0]); o[1] = ATT_MFMA(PP_PAF(0), PP_VFR(4), o[1]); o[0] = ATT_MFMA(PP_PAF(1), PP_VFR(1), o[0]); o[1] = ATT_MFMA(PP_PAF(1), PP_VFR(5), o[1]); \
      o[0] = ATT_MFMA(PP_PAF(2), PP_VFR(2), o[0]); o[1] = ATT_MFMA(PP_PAF(2), PP_VFR(6), o[1]); o[0] = ATT_MFMA(PP_PAF(3), PP_VFR(3), o[0]); o[1] = ATT_MFMA(PP_PAF(3), PP_VFR(7), o[1]); } while (0)
    int t = 1;
#pragma unroll 1
    for (; t + 1 < NT; t += 2) {
        PP_STEP(pB0, pB1, pA0, pA1, t);
        PP_STEP(pA0, pA1, pB0, pB1, t + 1);
    }
    if (t < NT) { PP_STEP(pB0, pB1, pA0, pA1, t); SBAR(); PP_DRAIN(pB0, pB1); }
    else { SBAR(); PP_DRAIN(pA0, pA1); }
    m_out = mhat; l_out = l_reg;
    ATT_BAR();
#undef PP_DMA_K
#undef PP_DMA_V
#undef PP_CB
#undef PP_QB
#undef PP_BIAS
#undef PP_BIAS0
#undef PP_ROT
#undef PP_STEP
#undef PP_DRAIN
}
struct NsaSeq {
    int vlist, NT; unsigned long long rmask; int c, tokloc, wblk;
    DEVI int desc(int i) const { return __builtin_amdgcn_readlane(vlist, i & 63); }
    DEVI int krow(int d) const { return 64 * (d & 63); }
    DEVI bool vis(int d) const { return !(d & 64) && ((rmask >> (d & 63)) & 1ull); }
    DEVI bool emask(int d) const { return d == c || d == wblk; }
    DEVI int lo(int d) const { return d == wblk ? tokloc + 1 : -BIG; }
    DEVI int hi_(int d) const { return d == c ? tokloc : BIG; }
};
struct MobaSeq {
    int cur, NT, widh, tq; unsigned sel;
    DEVI int desc(int i) const { return i; }
    DEVI int krow(int i) const { return (cur + 1) * 256 - 64 * (i + 1); }
    DEVI bool own(int i) const { return i < 4; }
    DEVI bool vis(int i) const { return own(i) ? ((3 - i) <= widh) : (((sel >> ((cur - (i >> 2)) & 31)) & 1u) != 0u); }
    DEVI bool emask(int i) const { return own(i) && (3 - i) == widh; }
    DEVI int lo(int) const { return -BIG; }
    DEVI int hi_(int i) const { return tq - 64 * (3 - i); }
};

template <class RowF>
DEVI void store_y(const ALAS float* ot, const bf16_t* Zb, bf16_t* Y, const RowF& rf, int lane) {
    u32x4 z[4];
#pragma unroll
    for (int i = 0; i < 4; ++i) { const int ci = i * 64 + lane, q = ci >> 3, ch = ci & 7; z[i] = *(const u32x4*)(Zb + rf.zoff(q) + ch * 8); }
#pragma unroll
    for (int i = 0; i < 4; ++i) {
        const int ci = i * 64 + lane, q = ci >> 3, ch = ci & 7;
        const f32x4 v0 = *(const ALAS f32x4*)(ot + q * 64 + ch * 8), v1 = *(const ALAS f32x4*)(ot + q * 64 + ch * 8 + 4);
        u32x4 w;
        w.x = cvtpk(v0[0] * __uint_as_float(z[i].x << 16), v0[1] * __uint_as_float(z[i].x & 0xffff0000u)); w.y = cvtpk(v0[2] * __uint_as_float(z[i].y << 16), v0[3] * __uint_as_float(z[i].y & 0xffff0000u));
        w.z = cvtpk(v1[0] * __uint_as_float(z[i].z << 16), v1[1] * __uint_as_float(z[i].z & 0xffff0000u)); w.w = cvtpk(v1[2] * __uint_as_float(z[i].w << 16), v1[3] * __uint_as_float(z[i].w & 0xffff0000u));
        *(u32x4*)(Y + rf.yoff(q) + ch * 8) = w;
    }
    ATT_LSYNC();
}

struct NsaRows { size_t hs; int rowb, g; DEVI size_t zoff(int q) const { return (size_t)(g * 4 + (q & 3)) * hs + (size_t)(rowb + (q >> 2)) * 64; } DEVI size_t yoff(int q) const { return (size_t)(rowb + (q >> 2)) * 1024 + (g * 4 + (q & 3)) * 64; } };
struct MobaRows { size_t hs; int rowb, h; DEVI size_t zoff(int q) const { return (size_t)(8 + h) * hs + (size_t)(rowb + q) * 64; } DEVI size_t yoff(int q) const { return (size_t)(rowb + q) * 1024 + 512 + h * 64; } };

DEVI void nsa_unit(const Params& P, lchar* L, const int b, const int g, const int c, const int wid) {
    const int lane = lane_id_opaque(), r32 = lane & 31, hi = lane >> 5;
    const bf16_t* ATT = (const bf16_t*)(P.ws + WS_ATT); const size_t HS = (size_t)MROWS * 64;
    lchar* Wv = L + L_WAVE + wid * WAVE_BYTES;
    ALAS float* wsf = (ALAS float*)(Wv + W_WSF); ALAS float* IMP = (ALAS float*)(Wv + W_IMP);
    ALAS unsigned long long* MASKS = (ALAS unsigned long long*)(Wv + W_MASK); ALAS float* OT = (ALAS float*)(Wv + W_OT);
    ALAS unsigned long long* WUN = (ALAS unsigned long long*)(L + L_WG);
    const int tokloc = wid * 8 + (r32 >> 2), hh = g * 4 + (r32 & 3);
    const int t = c * 64 + tokloc, row = b * SEQ + t;
    const float slope2 = exp2f(-(float)(2 * hh + 1) * 0.5f) * LOG2E;
    bf16x8 qr[4];
    { const bf16_t* qp = ATT + (size_t)(HC_QA + hh) * HS + (size_t)row * 64 + hi * 8;
#pragma unroll
      for (int d0 = 0; d0 < 4; ++d0) qr[d0] = *(const bf16x8*)(qp + d0 * 16); }
    const float* Gp = (const float*)(P.ws + WS_G) + (size_t)row * 24 + hh;
    unsigned long long U, wun = 0ull, mymask;
    Stage st;
    {
        const bf16_t* KCb = (const bf16_t*)(P.ws + WS_KC) + (size_t)(b * 2 + g) * 256 * 64; const bf16_t* VCb = (const bf16_t*)(P.ws + WS_VC) + (size_t)(b * 2 + g) * 256 * 64;
        const int nblk = ((4 * c + 2) >> 6) + 1, nlim = (t - 31) >> 4;
        f32x16 o[4];
#pragma unroll
        for (int d = 0; d < 4; ++d)
#pragma unroll
            for (int r = 0; r < 16; ++r) o[d][r] = 0.f;
        float m = 0.f, l = 0.f; bool first = true;
#define OV_TILE(bb, dstoff) do { const int p_ = wid * 64 + lane, dh_ = p_ >> 8, kk_ = (p_ >> 2) & 63, c4_ = p_ & 3, n_ = 64 * (bb) + kk_; \
            const int jr_ = (n_ >> 2) - (dh_ * 32 + c4_ * 8);                           \
            unsigned m8_ = ((unsigned)jr_ < 8u ? 1u << jr_ : 0u) | (((n_ & 3) == 3 && (unsigned)(jr_ + 1) < 8u) ? 1u << (jr_ + 1) : 0u); if (n_ >= 255) m8_ = 0u; \
            unsigned w_[4]; _Pragma("unroll") for (int e_ = 0; e_ < 4; ++e_) w_[e_] = ((m8_ >> (2 * e_)) & 1u) * 0x3F80u | ((m8_ >> (2 * e_ + 1)) & 1u) * 0x3F800000u; \
            *(ALAS u32x4*)(L + L_OVT + (dstoff) + dh_ * 4096 + kk_ * 64 + c4_ * 16) = (u32x4){w_[0], w_[1], w_[2], w_[3]}; } while (0)
        stage_load(st, KCb, VCb, wid, lane); stage_write(st, L + L_K, L + L_V, wid, lane); OV_TILE(0, 0); ATT_BAR();
        for (int i = 0; i < nblk; ++i) {
            const int buf = i & 1;
            if (i + 1 < nblk) stage_load(st, KCb + (i + 1) * 4096, VCb + (i + 1) * 4096, wid, lane);
            const float cbase = slope2 * (float)(16 * (64 * i + 4 * hi) + 31 - t);
            flash_block<4, true>(L + L_K + buf * 8192, L + L_V + buf * 8192, L + L_OVT + buf * 8192, qr, o, m, l, first, cbase, slope2 * 16.f, -BIG, nlim - 64 * i, wsf, lane);
            first = false;
            __builtin_amdgcn_sched_barrier(0);
            if (i + 1 < nblk) { stage_write(st, L + L_K + (buf ^ 1) * 8192, L + L_V + (buf ^ 1) * 8192, wid, lane); OV_TILE(i + 1, (buf ^ 1) * 8192); }
            ATT_BAR();
        }
        const float lt = swap_sum(l), rl = lt > 0.f ? 1.f / lt : 0.f;
        wsf[r32] = Gp[0] * rl; wsf[64 + r32] = rl; ATT_LSYNC();
#pragma unroll
        for (int d0 = 0; d0 < 2; ++d0)
#pragma unroll
            for (int r = 0; r < 16; ++r) OT[crow(r, hi) * 64 + d0 * 32 + r32] = o[d0][r] * wsf[crow(r, hi)];
#pragma unroll
        for (int d0 = 0; d0 < 2; ++d0)
#pragma unroll
            for (int g4 = 0; g4 < 4; ++g4) { float v = 0.f;
#pragma unroll
                for (int p = 0; p < 4; ++p) v += o[2 + d0][4 * g4 + p] * wsf[64 + crow(4 * g4 + p, hi)];
                IMP[(2 * g4 + hi) * 64 + d0 * 32 + r32] = v; }
        ATT_LSYNC();
#pragma unroll 1
        for (int tk = 0; tk < 8; ++tk) {
            float v = IMP[tk * 64 + lane];
            if (lane == 0 || lane == c || lane == c - 1) v = INFINITY;
            if (lane > c) v = -INFINITY;
            const unsigned bits = __float_as_uint(v), key = bits ^ ((bits & 0x80000000u) ? 0xffffffffu : 0x80000000u);
            unsigned T = 0u;
#pragma unroll 1
            for (int bit = 31; bit >= 0; --bit) { const unsigned cand = T | (1u << bit); const int cnt = __builtin_popcountll(__ballot(key >= cand)); if (cnt >= 16) { T = cand; if (cnt == 16) break; } }
            const unsigned long long gt = __ballot(key > T), eq = __ballot(key == T);
            const int need = 16 - __builtin_popcountll(gt);
            const int below = (int)__builtin_amdgcn_mbcnt_hi((unsigned)(eq >> 32), __builtin_amdgcn_mbcnt_lo((unsigned)eq, 0u));
            const bool selj = (key > T) || (key == T && below < need);
            const unsigned long long mk = __ballot(selj && lane <= c);
            if (lane == 0) MASKS[tk] = mk;
            wun |= mk; }
        if (lane == 0) WUN[wid] = wun;
        ATT_BAR();
        U = 0ull;
#pragma unroll
        for (int w = 0; w < 8; ++w) U |= WUN[w];
        U = ((unsigned long long)(unsigned)__builtin_amdgcn_readfirstlane((int)(U >> 32)) << 32) | (unsigned long long)(unsigned)__builtin_amdgcn_readfirstlane((int)(unsigned)U);
    }
    const int laneB = lane_id_opaque(), r32B = laneB & 31, hiB = laneB >> 5, toklocB = wid * 8 + (r32B >> 2), hhB = g * 4 + (r32B & 3), tB = c * 64 + toklocB;
    const float slope2B = exp2f(-(float)(2 * hhB + 1) * 0.5f) * LOG2E;
    const float* GpB = (const float*)(P.ws + WS_G) + (size_t)(b * SEQ + tB) * 24 + hhB;
    mymask = MASKS[r32B >> 2];
#pragma unroll
    for (int pass = 1; pass <= 2; ++pass) {
        const bf16_t* Kb = ATT + (size_t)((pass == 1 ? HC_KS : HC_KW) + g) * HS + (size_t)b * SEQ * 64;
        const bf16_t* Vb = ATT + (size_t)((pass == 1 ? HC_VS : HC_VW) + g) * HS + (size_t)b * SEQ * 64;
        const int jlow = c >= 8 ? c - 8 : 0;
        const unsigned long long upto = (c == 63) ? ~0ull : ((1ull << (c + 1)) - 1ull);
        const unsigned long long Ucur = (pass == 1) ? U : (upto & ~((1ull << jlow) - 1ull));
        const unsigned long long wneed = (pass == 1) ? wun : ~0ull, rmask = (pass == 1) ? mymask : ~0ull;
        f32x16 o[2];
#pragma unroll
        for (int d = 0; d < 2; ++d)
#pragma unroll
            for (int r = 0; r < 16; ++r) o[d][r] = 0.f;
        float m = 0.f, l = 0.f;
        ALAS unsigned char* TL = (ALAS unsigned char*)(L + L_TL);
        const int ntraw = (int)__builtin_popcountll(Ucur);
        if (wid == 0 && laneB == 0) TL[ntraw] = (unsigned char)64;
        if (wid == 0 && ((Ucur >> laneB) & 1ull)) TL[__builtin_popcountll(laneB == 63 ? 0ull : (Ucur >> (laneB + 1)))] = (unsigned char)laneB;
        ATT_BAR();
        const NsaSeq seq{(int)TL[laneB], ntraw, rmask, c, toklocB, (pass == 2 && c >= 8) ? c - 8 : -1};
        pipe_pass(L, seq, Kb, Vb, qr, o, m, l, slope2B, tB, wsf, wid, laneB);
        const float lt = swap_sum(l), rl = lt > 0.f ? 1.f / lt : 0.f;
        wsf[r32B] = GpB[8 * pass] * rl; ATT_LSYNC();
#pragma unroll
        for (int d0 = 0; d0 < 2; ++d0)
#pragma unroll
            for (int r = 0; r < 16; ++r) OT[crow(r, hiB) * 64 + d0 * 32 + r32B] += o[d0][r] * wsf[crow(r, hiB)];
        ATT_LSYNC();
    }
    const NsaRows rf{HS, b * SEQ + c * 64 + wid * 8, g};
    store_y(OT, (const bf16_t*)(P.ws + WS_Z), (bf16_t*)(P.ws + WS_Y), rf, laneB);
}

DEVI void moba_unit(const Params& P, lchar* L, const int b, const int h, const int cur, const int wid) {
    const int lane = lane_id_opaque(), r32 = lane & 31, hi = lane >> 5; const int tid = wid * 64 + lane;
    const bf16_t* ATT = (const bf16_t*)(P.ws + WS_ATT); const size_t HS = (size_t)MROWS * 64;
    lchar* Wv = L + L_WAVE + wid * WAVE_BYTES;
    ALAS float* wsf = (ALAS float*)(Wv + W_WSF); ALAS float* OT = (ALAS float*)(Wv + W_OT);
    const int tq = 32 * wid + r32, t = cur * 256 + tq, row = b * SEQ + t;
    const float slope2 = exp2f(-(float)(h + 1)) * LOG2E;
    bf16x8 qr[4];
    { const bf16_t* qp = ATT + (size_t)(HC_QB + h) * HS + (size_t)row * 64 + hi * 8;
#pragma unroll
      for (int d0 = 0; d0 < 4; ++d0) qr[d0] = *(const bf16x8*)(qp + d0 * 16); }
    unsigned sel = 0u;
    if (cur > 0) {
        const float* kbp = (const float*)(P.ws + WS_KBAR) + (size_t)((b * 8 + h) * 16) * 64;
        lchar* KH = L + L_KBT; lchar* KL = L + L_KBT + 4096;
        for (int e = tid; e < 1024; e += NT) { const int key = e >> 6, d = e & 63; const float v = kbp[e]; const bf16_t vh = f2bf(v), vl = f2bf(v - bf2f(vh));
            const int off = (d >> 3) * 512 + key * 16 + (d & 7) * 2; *(ALAS bf16_t*)(KH + off) = vh; *(ALAS bf16_t*)(KL + off) = vl; }
        ATT_BAR();
        f32x16 ga;
#pragma unroll
        for (int r = 0; r < 16; ++r) ga[r] = 0.f;
        const lchar* kh = KH + hi * 512 + r32 * 16; const lchar* kl = KL + hi * 512 + r32 * 16;
#pragma unroll
        for (int d0 = 0; d0 < 4; ++d0) { ga = ATT_MFMA(*(const ALAS bf16x8*)(kh + d0 * 1024), qr[d0], ga); ga = ATT_MFMA(*(const ALAS bf16x8*)(kl + d0 * 1024), qr[d0], ga); }
        float own[8], oth[8], G[16];
#pragma unroll
        for (int r = 0; r < 8; ++r) { own[r] = ga[r]; oth[r] = swap_other(own[r], hi); }
#pragma unroll
        for (int idx = 0; idx < 16; ++idx) { const int half = (idx >> 2) & 1, rs = (idx & 3) + 4 * (idx >> 3); const float v = (half == hi) ? own[rs] : oth[rs]; G[idx] = (idx < cur) ? v : -INFINITY; }
#pragma unroll
        for (int k = 0; k < 3; ++k) { float best = -INFINITY; int bi = -1;
#pragma unroll
            for (int idx = 0; idx < 16; ++idx) { const bool ok = (G[idx] > best) && !((sel >> idx) & 1u); best = ok ? G[idx] : best; bi = ok ? idx : bi; }
            if (bi >= 0) sel |= 1u << bi; }
    }
    const bf16_t* Kb = ATT + (size_t)(HC_KB + h) * HS + (size_t)b * SEQ * 64; const bf16_t* Vb = ATT + (size_t)(HC_VB + h) * HS + (size_t)b * SEQ * 64;
    f32x16 o[2];
#pragma unroll
    for (int d = 0; d < 2; ++d)
#pragma unroll
        for (int r = 0; r < 16; ++r) o[d][r] = 0.f;
    float m = 0.f, l = 0.f;
    const MobaSeq seq{cur, 4 * (cur + 1), wid >> 1, tq, sel};
    pipe_pass(L, seq, Kb, Vb, qr, o, m, l, slope2, t, wsf, wid, lane);
    const float lt = swap_sum(l), rl = lt > 0.f ? 1.f / lt : 0.f;
    wsf[r32] = rl; ATT_LSYNC();
#pragma unroll
    for (int d0 = 0; d0 < 2; ++d0)
#pragma unroll
        for (int r = 0; r < 16; ++r) OT[crow(r, hi) * 64 + d0 * 32 + r32] = o[d0][r] * wsf[crow(r, hi)];
    ATT_LSYNC();
    const MobaRows rf{HS, b * SEQ + cur * 256 + wid * 32, h};
    store_y(OT, (const bf16_t*)(P.ws + WS_Z), (bf16_t*)(P.ws + WS_Y), rf, lane);
}


DEVI void phase_compress(const Params& P, lchar* L, const int wid) {
    const int lane = lane_id_opaque(), r32 = lane & 31, hi = lane >> 5;
    const bf16_t* ATT = (const bf16_t*)(P.ws + WS_ATT); const size_t HS = (size_t)MROWS * 64;
    constexpr int HP = 272;
    const int wm = wid >> 2, wn = wid & 3;
#pragma unroll 1
    for (int item = blockIdx.x; item < 256; item += gridDim.x) {
        const int q = item & 3, inst = item >> 2, g = inst & 1, b = (inst >> 1) & 15, which = inst >> 5;
        const bf16_t* X = ATT + (size_t)((which ? HC_VCMP : HC_KCMP) + g) * HS + (size_t)b * SEQ * 64;
        const bf16_t* W1T = (const bf16_t*)(P.ws + (which ? WS_W1V : WS_W1K)); const bf16_t* W2T = (const bf16_t*)(P.ws + (which ? WS_W2V : WS_W2K));
        const float* B1P = (const float*)(P.ws + WS_B1P) + which * 8 * 128;
        bf16_t* OUT = (bf16_t*)(P.ws + (which ? WS_VC : WS_KC)) + (size_t)((b * 2 + g) * 256 + 64 * q) * 64;
        const int n0 = 64 * q + 32 * wm, e0 = 32 * wn;
        f32x16 acc;
#pragma unroll
        for (int r = 0; r < 16; ++r) acc[r] = 0.f;
        {
            constexpr int SLOT = 24576, XO = 16384, HOFF = 4 * SLOT;
            const unsigned lbase = (unsigned)(uintptr_t)L;
            const int ul = lane >> 4, sl = lane & 15;
            unsigned woff[2], xoff;
#pragma unroll
            for (int j = 0; j < 2; ++j) { const int u = 4 * wid + ul + 32 * j, val = sl ^ (u & 15); woff[j] = (unsigned)((2 * u + (val >> 3)) * 4096 + (val & 7) * 16); }
            { const int u = 4 * wid + ul, val = sl ^ (u & 15); xoff = (unsigned)((2 * u + (val >> 3)) * 2048 + (val & 7) * 16); }
            const char* Wb = (const char*)W1T; const char* Xb = (const char*)(X + (size_t)(64 * q) * 1024);
#define CMP_ISSUE(c_) do { const unsigned d_ = lbase + (unsigned)(((c_) & 3) * SLOT) + (unsigned)wid * 1024u; \
                glds16s(Wb + (size_t)(c_) * 128, woff[0], (unsigned)__builtin_amdgcn_readfirstlane((int)d_)); glds16s(Wb + (size_t)(c_) * 128, woff[1], (unsigned)__builtin_amdgcn_readfirstlane((int)(d_ + 8192u))); \
                glds16s(Xb + (size_t)(c_) * 128, xoff, (unsigned)__builtin_amdgcn_readfirstlane((int)(d_ + (unsigned)XO))); } while (0)
            int aad[4], bad[4];
            { const int ra = e0 + r32, ua = ra >> 1, ca = (((ra & 1) << 3) | hi) ^ (ua & 15); const int rb = 32 * wm + r32, ub = rb >> 1, cb = (((rb & 1) << 3) | hi) ^ (ub & 15);
#pragma unroll
              for (int ks = 0; ks < 4; ++ks) { aad[ks] = ua * 256 + ((ca ^ (2 * ks)) * 16); bad[ks] = XO + ub * 256 + ((cb ^ (2 * ks)) * 16); } }
            asm volatile("s_waitcnt vmcnt(0)" ::: "memory");
            CMP_ISSUE(0); CMP_ISSUE(1); CMP_ISSUE(2);
#pragma unroll 1
            for (int c = 0; c < 32; ++c) {
                if (c + 2 < 32) asm volatile("s_waitcnt vmcnt(6) lgkmcnt(0)\n\ts_barrier" ::: "memory");
                else if (c + 1 < 32) asm volatile("s_waitcnt vmcnt(3) lgkmcnt(0)\n\ts_barrier" ::: "memory");
                else asm volatile("s_waitcnt vmcnt(0) lgkmcnt(0)\n\ts_barrier" ::: "memory");
                if (c + 3 < 32) CMP_ISSUE(c + 3);
                const lchar* sb = L + (c & 3) * SLOT;
#pragma unroll
                for (int ks = 0; ks < 4; ++ks) { const bf16x8 a = *(const ALAS bf16x8*)(sb + aad[ks]), bb = *(const ALAS bf16x8*)(sb + bad[ks]); acc = ATT_MFMA(a, bb, acc); }
            }
#undef CMP_ISSUE
            (void)HOFF;
        }
#pragma unroll
        for (int g4 = 0; g4 < 4; ++g4) { float v[4];
#pragma unroll
            for (int j = 0; j < 4; ++j) { const int e = e0 + 8 * g4 + 4 * hi + j; float bs = 0.f;
#pragma unroll
                for (int c = 0; c < 8; ++c) bs += B1P[c * 128 + e];
                const float x = acc[4 * g4 + j] + bs; v[j] = x * __builtin_amdgcn_rcpf(1.f + __builtin_amdgcn_exp2f(-1.4426950408889634f * x)); }
            u32x2 w; w.x = cvtpk(v[0], v[1]); w.y = cvtpk(v[2], v[3]);
            *(ALAS u32x2*)(L + 98304 + (32 * wm + r32) * HP + (e0 + 8 * g4 + 4 * hi) * 2) = w; }
        ATT_BAR();
        if (wid < 4) {
            const int wm2 = wid >> 1, f0 = 32 * (wid & 1);
            f32x16 a2;
#pragma unroll
            for (int r = 0; r < 16; ++r) a2[r] = 0.f;
            const lchar* hp = L + 98304 + (32 * wm2 + r32) * HP + hi * 16; const bf16_t* wp = W2T + (size_t)(f0 + r32) * 128 + hi * 8;
#pragma unroll
            for (int ks = 0; ks < 8; ++ks) { const bf16x8 a = *(const ALAS bf16x8*)(hp + ks * 32), bb = *(const bf16x8*)(wp + ks * 16); a2 = ATT_MFMA(a, bb, a2); }
#pragma unroll
            for (int r = 0; r < 16; ++r) { const int nl = 32 * wm2 + crow(r, hi); const bool pad = (64 * q + nl == 255);
                OUT[(size_t)nl * 64 + f0 + r32] = pad ? (bf16_t)0 : f2bf(a2[r]); }
        }
        ATT_BAR();
    }
    { const int gw = blockIdx.x * (NT / 64) + wid, ngw = (gridDim.x * NT) >> 6; float* KBAR = (float*)(P.ws + WS_KBAR);
      for (int it = gw; it < NB * 8 * 16; it += ngw) { const int n = it & 15, h = (it >> 4) & 7, b = it >> 7;
          const bf16_t* src = ATT + ((size_t)(HC_KB + h) * MROWS + (size_t)b * SEQ + n * 256) * 64; float s0 = 0.f, s1 = 0.f, s2 = 0.f, s3 = 0.f;
          for (int r = 0; r < 256; r += 4) { s0 += bf2f(src[r * 64 + lane]); s1 += bf2f(src[(r + 1) * 64 + lane]); s2 += bf2f(src[(r + 2) * 64 + lane]); s3 += bf2f(src[(r + 3) * 64 + lane]); }
          KBAR[(size_t)it * 64 + lane] = ((s0 + s1) + (s2 + s3)) * (1.f / 256.f); } }
}

DEVI void phase_attention(const Params& P, lchar* L, const int wid) {
    const int tid = wid * 64 + lane_id_opaque();
    const int G = gridDim.x, k = blockIdx.x;
    const int nU = (G == 256) ? 8 : ((2048 - k + G - 1) / G);
#pragma unroll 1
    for (int rep_ = 0; rep_ < 1 + PROBE_NSA2; ++rep_)
#pragma unroll 1
    for (int i = 0; i < (NAIVE_NSA ? 0 : nU); ++i) { int bg, c;
        if (G == 256) { bg = k & 31; const int base = k >> 5; c = 8 * i + ((i & 1) ? 7 - base : base); } else { const int u = k + i * G; bg = u & 31; c = u >> 5; }
        nsa_unit(P, L, bg >> 1, bg & 1, c, wid); }
#pragma unroll 1
    for (int rep_ = 0; rep_ < 1 + PROBE_MOBA2; ++rep_)
#pragma unroll 1
    for (int i = 0; i < (NAIVE_MOBA ? 0 : nU); ++i) { int bh, cur;
        if (G == 256) { bh = k & 127; const int base = k >> 7; cur = 2 * i + ((i & 1) ? 1 - base : base); } else { const int u = k + i * G; bh = u & 127; cur = u >> 7; }
        moba_unit(P, L, bh >> 3, bh & 7, cur, wid); }
}
}

DEVI void phase_final(const Params& P, const int wid) {
    const int lane = lane_id_opaque(), gw = blockIdx.x * (NT / 64) + wid, ngw = (gridDim.x * NT) >> 6;
    const float* SS = (const float*)(P.ws + WS_SS); const bf16_t* T = (const bf16_t*)(P.ws + WS_M1);
    constexpr int RF = 4;
    for (int r = gw * RF; r < MROWS; r += RF * ngw) {
        float4 sv[16];
#pragma unroll
        for (int j = 0; j < 16; ++j) sv[j] = *(const float4*)(SS + (size_t)j * MROWS + r);
        uint4 tw[RF][2]; float4 xa[RF][2], xb[RF][2];
#pragma unroll
        for (int q = 0; q < RF; ++q)
#pragma unroll
            for (int j = 0; j < 2; ++j) { const int c = j * 512 + lane * 8; const size_t o = (size_t)(r + q) * DM + c;
                tw[q][j] = *(const uint4*)(T + o); { typedef float f4v_ __attribute__((ext_vector_type(4))); const f4v_ t0_ = __builtin_nontemporal_load((const f4v_*)(P.x + o)), t1_ = __builtin_nontemporal_load((const f4v_*)(P.x + o + 4)); xa[q][j] = make_float4(t0_[0], t0_[1], t0_[2], t0_[3]); xb[q][j] = make_float4(t1_[0], t1_[1], t1_[2], t1_[3]); } }
        float ss[RF] = {0.f, 0.f, 0.f, 0.f};
#pragma unroll
        for (int j = 0; j < 16; ++j) { ss[0] += sv[j].x; ss[1] += sv[j].y; ss[2] += sv[j].z; ss[3] += sv[j].w; }
#pragma unroll
        for (int q = 0; q < RF; ++q) { const float rs = rsqrtf(ss[q] * (1.f / DM) + RMS_EPS); float* orow = P.out + (size_t)(r + q) * DM;
#pragma unroll
            for (int j = 0; j < 2; ++j) { const int c = j * 512 + lane * 8; const float4 g0 = *(const float4*)(P.norm_post + c), g1 = *(const float4*)(P.norm_post + c + 4);
                const uint4 t4 = tw[q][j]; const float4 x0 = xa[q][j], x1 = xb[q][j]; float4 o0, o1;
                o0.x = x0.x + __uint_as_float(t4.x << 16) * rs * g0.x; o0.y = x0.y + __uint_as_float(t4.x & 0xffff0000u) * rs * g0.y; o0.z = x0.z + __uint_as_float(t4.y << 16) * rs * g0.z; o0.w = x0.w + __uint_as_float(t4.y & 0xffff0000u) * rs * g0.w;
                o1.x = x1.x + __uint_as_float(t4.z << 16) * rs * g1.x; o1.y = x1.y + __uint_as_float(t4.z & 0xffff0000u) * rs * g1.y; o1.z = x1.z + __uint_as_float(t4.w << 16) * rs * g1.z; o1.w = x1.w + __uint_as_float(t4.w & 0xffff0000u) * rs * g1.w;
                { typedef float f4v_ __attribute__((ext_vector_type(4))); const f4v_ s0_ = {o0.x, o0.y, o0.z, o0.w}, s1_ = {o1.x, o1.y, o1.z, o1.w}; __builtin_nontemporal_store(s0_, (f4v_*)(orow + c)); __builtin_nontemporal_store(s1_, (f4v_*)(orow + c + 4)); } } }
    }
}

DEVI void tree_barrier(unsigned* ctl, const int wid) {
    asm volatile("s_waitcnt vmcnt(0) lgkmcnt(0)" ::: "memory");
    __builtin_amdgcn_s_barrier();
    if (wid == 0 && lane_id() == 0) {
        __builtin_amdgcn_fence(__ATOMIC_RELEASE, "agent");
        const unsigned G = gridDim.x, ng = G < 16u ? G : 16u, g = blockIdx.x % ng, gsz = G / ng + (g < G % ng ? 1u : 0u);
        const unsigned old = __hip_atomic_fetch_add(ctl + g * 32, 1u, __ATOMIC_RELAXED, __HIP_MEMORY_SCOPE_AGENT);
        if (old == gsz - 1u) {
            const unsigned o2 = __hip_atomic_fetch_add(ctl + 512, 1u, __ATOMIC_RELAXED, __HIP_MEMORY_SCOPE_AGENT);
            if (o2 == ng - 1u) __hip_atomic_store(ctl + 544, 1u, __ATOMIC_RELAXED, __HIP_MEMORY_SCOPE_AGENT);
        }
        while (__hip_atomic_load(ctl + 544, __ATOMIC_RELAXED, __HIP_MEMORY_SCOPE_AGENT) == 0u) __builtin_amdgcn_s_sleep(1);
        __builtin_amdgcn_fence(__ATOMIC_ACQUIRE, "agent");
    }
    __builtin_amdgcn_s_barrier();
}

constexpr int LDS_BYTES = 163840;
__global__ void __launch_bounds__(NT, 2) fwd_kernel(Params P) {
    extern __shared__ __attribute__((aligned(16))) unsigned char lds_raw[];
    float* lds = (float*)lds_raw;
    PG8_LAS unsigned char* ring = (PG8_LAS unsigned char*)lds_raw;
    __builtin_assume(__builtin_amdgcn_workitem_id_y() == 0); __builtin_assume(__builtin_amdgcn_workitem_id_z() == 0);
    cg::grid_group grid = cg::this_grid();
    const int wid = __builtin_amdgcn_readfirstlane(threadIdx.x >> 6);
    const int lo = P.ph_lo, hi = P.ph_hi;
#define IN(k) (lo <= (k) && (k) < hi)
#define SEAM0() do { if (IN(0) && IN(1)) { asm volatile("s_waitcnt vmcnt(0) lgkmcnt(0)" ::: "memory"); grid.sync(); } } while (0)
#define SEAM(k) do { if (IN(k) && IN((k) + 1)) tree_barrier((unsigned*)(P.ws + WS_CTL) + (k) * 1024, wid); } while (0)
    if (IN(0)) { if (blockIdx.x == 0) { unsigned* ctl = (unsigned*)(P.ws + WS_CTL); for (int i = wid * 64 + lane_id(); i < 8 * 1024; i += NT) ctl[i] = 0u; }
        phase_prep(P, lds); }
    SEAM0();
    if (IN(1)) { if (blockIdx.x & 8) { for (int i_ = 0; i_ < 4; ++i_) __builtin_amdgcn_s_sleep(127); }
        pg8::Gemm g{(const bf16_t*)(P.ws + WS_U), (const bf16_t*)(P.ws + WS_WIN), MROWS, NPROJ, DM}; pg8::StaticOrder S; S.init(MROWS, NPROJ, (int)gridDim.x, (int)blockIdx.x);
        pg8::EpiProj E{(bf16_t*)(P.ws + WS_ATT), (bf16_t*)(P.ws + WS_Z), (bf16_t*)(P.ws + WS_MRG), (float*)(P.ws + WS_G)};
        pg8::gemm_phase<pg8::EpiProj, pg8::StaticOrder, true, true>(ring, g, S, E, wid); }
    SEAM(1);
    if (IN(2)) att::phase_compress(P, (att::lchar*)lds_raw, wid);
    SEAM(2);
    if (IN(3)) att::phase_attention(P, (att::lchar*)lds_raw, wid);
    SEAM(3);
    if (IN(4)) { pg8::Gemm g{(const bf16_t*)(P.ws + WS_Y), (const bf16_t*)(P.ws + WS_WA), MROWS, 1024, 1024}; pg8::StaticOrder S; S.init(MROWS, 1024, (int)gridDim.x, (int)blockIdx.x);
        pg8::EpiMG E{(const bf16_t*)(P.ws + WS_MRG), (bf16_t*)(P.ws + WS_MM)};
        pg8::gemm_phase<pg8::EpiMG, pg8::StaticOrder, true, true>(ring, g, S, E, wid); }
    SEAM(5);
    if (IN(6)) { pg8::Gemm g{(const bf16_t*)(P.ws + WS_MM), (const bf16_t*)(P.ws + WS_WO), MROWS, 1024, 1024}; pg8::StaticOrder S; S.init(MROWS, 1024, (int)gridDim.x, (int)blockIdx.x);
        pg8::EpiOut E{(bf16_t*)(P.ws + WS_M1), (float*)(P.ws + WS_SS)};
        pg8::gemm_phase<pg8::EpiOut, pg8::StaticOrder, true, true>(ring, g, S, E, wid); }
    SEAM(6);
    if (IN(7)) phase_final(P, wid);
#undef IN
#undef SEAM
}

extern "C" void kernel_launch(void* const* d_in, const int* in_sizes, int n_in, void* d_out, int out_size, void* d_ws, size_t ws_size, hipStream_t stream) {
    static int grid = 0;
    if (grid == 0) {
        if (n_in != 13 || out_size != MROWS * DM || ws_size < WS_END) { fprintf(stderr, "kernel_launch: unexpected shapes (n_in %d out %d ws %zu)\n", n_in, out_size, ws_size); grid = -1; return; }
        int dev = 0, cus = 0, per_cu = 0;
        (void)hipGetDevice(&dev); (void)hipDeviceGetAttribute(&cus, hipDeviceAttributeMultiprocessorCount, dev);
        if (hipFuncSetAttribute((const void*)fwd_kernel, hipFuncAttributeMaxDynamicSharedMemorySize, LDS_BYTES) != hipSuccess) { fprintf(stderr, "kernel_launch: hipFuncSetAttribute failed\n"); grid = -1; return; }
        (void)hipOccupancyMaxActiveBlocksPerMultiprocessor(&per_cu, (const void*)fwd_kernel, NT, LDS_BYTES);
        if (per_cu < 1) { fprintf(stderr, "kernel_launch: occupancy query says %d blocks per CU\n", per_cu); }
        (void)hipGetLastError();
        grid = cus;
    }
    if (grid < 0) return;
    Params p{};
    p.x = (const float*)d_in[0]; p.norm_pre = (const float*)d_in[1]; p.w_in = (const float*)d_in[2];
    p.pe_k = (const float*)d_in[3]; p.w1_k = (const float*)d_in[4]; p.w2_k = (const float*)d_in[5];
    p.pe_v = (const float*)d_in[6]; p.w1_v = (const float*)d_in[7]; p.w2_v = (const float*)d_in[8];
    p.w_a = (const float*)d_in[9]; p.w_b = (const float*)d_in[10]; p.w_o = (const float*)d_in[11]; p.norm_post = (const float*)d_in[12];
    p.out = (float*)d_out; p.ws = (unsigned char*)d_ws;
#if MK_N_LAUNCHES == 1
    p.ph_lo = 0; p.ph_hi = NPHASE;
    void* args[] = {&p};
    hipError_t e = hipLaunchCooperativeKernel((const void*)fwd_kernel, dim3(grid), dim3(NT), args, LDS_BYTES, stream);
    if (e != hipSuccess) fprintf(stderr, "cooperative launch failed: %s (grid %d)\n", hipGetErrorString(e), grid);
#else
    for (int ph = 0; ph < 8; ++ph) { p.ph_lo = ph; p.ph_hi = ph + 1; hipLaunchKernelGGL(fwd_kernel, dim3(grid), dim3(NT), LDS_BYTES, stream, p); }
#endif
}
```

```cpp
#include <hip/hip_runtime.h>
#include <hip/hip_cooperative_groups.h>
#include <cstdio>
#include <cstdint>
namespace cg = cooperative_groups;

#ifndef MK_N_LAUNCHES
#define MK_N_LAUNCHES 1
#endif

typedef unsigned short bf16_t;
#define DEVI __device__ __forceinline__

constexpr int NB = 16, SEQ = 4096, MROWS = NB * SEQ, DM = 1024;
constexpr int INCOLS = 5912, NPROJ = 6144;
constexpr float RMS_EPS = 1e-6f;
constexpr float LOG2E = 1.4426950408889634f;
constexpr float C2 = 0.125f * LOG2E;
constexpr int NT = 512;
constexpr int NPHASE = 10;

constexpr size_t MiB = 1u << 20;
constexpr size_t WS_CTL = 0;
constexpr size_t WS_WIN = 1 * MiB;
constexpr size_t WS_WA = 13 * MiB;
constexpr size_t WS_WB = 14 * MiB;
constexpr size_t WS_WO = 15 * MiB;
constexpr size_t WS_W1K = 17 * MiB;
constexpr size_t WS_W1V = 17 * MiB + 512 * 1024;
constexpr size_t WS_W2K = 21 * MiB;
constexpr size_t WS_W2V = 21 * MiB + 64 * 1024;
constexpr size_t WS_B1P = 21 * MiB + 128 * 1024;
constexpr size_t WS_KC = 18 * MiB;
constexpr size_t WS_VC = 19 * MiB;
constexpr size_t WS_KBAR = 20 * MiB;
constexpr size_t WS_G = 26 * MiB;
constexpr size_t WS_U = 32 * MiB;
constexpr size_t WS_Y = WS_U;
constexpr size_t WS_YB = WS_U + 64 * MiB;
constexpr size_t WS_SS = 22 * MiB;
constexpr size_t WS_ATT = 160 * MiB;
constexpr size_t WS_Z = 512 * MiB;
constexpr size_t WS_MRG = 640 * MiB;
constexpr size_t WS_M1 = 160 * MiB;
constexpr size_t WS_MM = 512 * MiB;
constexpr size_t WS_END = 896 * MiB;

constexpr int HC_QA = 0, HC_KCMP = 8, HC_VCMP = 10, HC_KS = 12, HC_VS = 14, HC_KW = 16, HC_VW = 18, HC_QB = 20, HC_KB = 28, HC_VB = 36;

struct Params {
    const float *x, *norm_pre, *w_in, *pe_k, *w1_k, *w2_k, *pe_v, *w1_v, *w2_v, *w_a, *w_b, *w_o, *norm_post;
    float* out; unsigned char* ws; int ph_lo, ph_hi;
};

DEVI float bf2f(bf16_t b) { return __uint_as_float((unsigned)b << 16); }
DEVI bf16_t f2bf(float f) { unsigned u = __float_as_uint(f); return (bf16_t)((u + 0x7fffu + ((u >> 16) & 1u)) >> 16); }
DEVI float wave_max(float v) {
#pragma unroll
    for (int o = 32; o; o >>= 1) v = fmaxf(v, __shfl_xor(v, o));
    return v;
}
DEVI float wave_sum(float v) {
#pragma unroll
    for (int o = 32; o; o >>= 1) v += __shfl_xor(v, o);
    return v;
}
DEVI float sigmoidf_(float x) { return 1.f / (1.f + __expf(-x)); }
DEVI float siluf_(float x) { return x / (1.f + __expf(-x)); }
#define LDS_SYNC() asm volatile("s_waitcnt lgkmcnt(0)" ::: "memory")
DEVI int lane_id() { return (int)(__builtin_amdgcn_mbcnt_hi(~0u, __builtin_amdgcn_mbcnt_lo(~0u, 0u)) & 63u); }
DEVI int lane_id_opaque() { int l = lane_id(); asm volatile("" : "+v"(l)); return l; }

DEVI int orig_col(int n) {
    if (n < 1280) return n;
    if (n < 3840) return n + 24;
    if (n < 5888) { const int j = n - 3840, t = j >> 8, w = j & 255; return 3864 + ((w & 32) ? 1024 : 0) + t * 128 + (w >> 6) * 32 + (w & 31); }
    return n - 5888 + 1280;
}
DEVI void prep_transpose_item(const float* W, int N, int src_col0, int nvalid, bf16_t* WT, int K, int dst_row0, int k0, float* scr, int lane, int dst_k_off = 0) {
    { float4 v[8]; const int c4 = (lane & 7) * 4;
#pragma unroll
      for (int i = 0; i < 8; ++i) { const int kk = 8 * i + (lane >> 3); v[i] = (c4 < nvalid) ? *(const float4*)(W + (size_t)(k0 + kk) * N + src_col0 + c4) : make_float4(0.f, 0.f, 0.f, 0.f); }
#pragma unroll
      for (int i = 0; i < 8; ++i) { const int kk = 8 * i + (lane >> 3); float* q = scr + kk * 33 + c4; q[0] = v[i].x; q[1] = v[i].y; q[2] = v[i].z; q[3] = v[i].w; } }
    LDS_SYNC();
    const int c8 = lane & 7;
#pragma unroll
    for (int j = 0; j < 4; ++j) { const int n = (lane >> 3) + 8 * j; const float* p = scr + (8 * c8) * 33 + n;
        uint4 o; o.x = (unsigned)f2bf(p[0]) | ((unsigned)f2bf(p[33]) << 16); o.y = (unsigned)f2bf(p[2 * 33]) | ((unsigned)f2bf(p[3 * 33]) << 16);
        o.z = (unsigned)f2bf(p[4 * 33]) | ((unsigned)f2bf(p[5 * 33]) << 16); o.w = (unsigned)f2bf(p[6 * 33]) | ((unsigned)f2bf(p[7 * 33]) << 16);
        *(uint4*)(WT + (size_t)(dst_row0 + n) * K + dst_k_off + k0 + 8 * c8) = o; }
    LDS_SYNC();
}
DEVI void phase_prep(const Params& P, float* lds) {
    bf16_t* WinT = (bf16_t*)(P.ws + WS_WIN); bf16_t* WaT = (bf16_t*)(P.ws + WS_WA); bf16_t* WbT = (bf16_t*)(P.ws + WS_WB); bf16_t* WoT = (bf16_t*)(P.ws + WS_WO);
    {
        const int lane = threadIdx.x & 63, wv = threadIdx.x >> 6, gw = (blockIdx.x * NT + threadIdx.x) >> 6, ngw = (gridDim.x * NT) >> 6;
        float* scr = lds + wv * 4096;
        constexpr int I_IN = 16 * 192, I_AB = 8 * 32, I_O = 16 * 32, I_W1 = 32 * 4, I_W2 = 2 * 2, I_B1 = 32;
        for (int it = gw; it < I_IN + 2 * I_AB + I_O + 2 * I_W1 + 2 * I_W2 + I_B1; it += ngw) {
            int r = it;
            if (r < I_IN) { const int kb = r / 192, nb = r % 192, n0 = nb * 32; const int nvalid = n0 + 32 <= INCOLS ? 32 : (n0 < INCOLS ? INCOLS - n0 : 0);
                prep_transpose_item(P.w_in, INCOLS, nvalid ? orig_col(n0) : 0, nvalid, WinT, DM, n0, kb * 64, scr, lane); continue; }
            r -= I_IN;
            if (r < I_AB) { prep_transpose_item(P.w_a, 1024, (r % 32) * 32, 32, WaT, 1024, (r % 32) * 32, (r / 32) * 64, scr, lane); continue; }
            r -= I_AB;
            if (r < I_AB) { prep_transpose_item(P.w_b, 1024, (r % 32) * 32, 32, WaT, 1024, (r % 32) * 32, (r / 32) * 64, scr, lane, 512); continue; }
            r -= I_AB;
            if (r < I_O) { prep_transpose_item(P.w_o, 1024, (r % 32) * 32, 32, WoT, 1024, (r % 32) * 32, (r / 32) * 64, scr, lane); continue; }
            r -= I_O;
            if (r < 2 * I_W1) { const int wh = r / I_W1, q = r % I_W1;
                prep_transpose_item(wh ? P.w1_v : P.w1_k, 128, (q % 4) * 32, 32, (bf16_t*)(P.ws + (wh ? WS_W1V : WS_W1K)), 2048, (q % 4) * 32, (q / 4) * 64, scr, lane); continue; }
            r -= 2 * I_W1;
            if (r < 2 * I_W2) { const int wh = r / I_W2, q = r % I_W2;
                prep_transpose_item(wh ? P.w2_v : P.w2_k, 64, (q % 2) * 32, 32, (bf16_t*)(P.ws + (wh ? WS_W2V : WS_W2K)), 128, (q % 2) * 32, (q / 2) * 64, scr, lane); continue; }
            r -= 2 * I_W2;
            { const int wh = r >> 4, eh = (r >> 3) & 1, ch = r & 7;
              const float* pe = wh ? P.pe_v : P.pe_k; const float* w1 = wh ? P.w1_v : P.w1_k; float acc = 0.f;
              for (int kk = ch * 256; kk < ch * 256 + 256; ++kk) acc += pe[kk] * w1[(size_t)kk * 128 + eh * 64 + lane];
              ((float*)(P.ws + WS_B1P))[(wh * 8 + ch) * 128 + eh * 64 + lane] = acc; }
        }
    }
    bf16_t* U = (bf16_t*)(P.ws + WS_U);
    const int lane = threadIdx.x & 63, gw = (blockIdx.x * NT + threadIdx.x) >> 6, ngw = (gridDim.x * NT) >> 6;
    typedef float f4_t __attribute__((ext_vector_type(4)));
    typedef float f2_t __attribute__((ext_vector_type(2)));
    typedef __bf16 b2_t __attribute__((ext_vector_type(2)));
    typedef unsigned u2_t __attribute__((ext_vector_type(2)));
    constexpr int RF = 4;
    for (int r = gw * RF; r < MROWS; r += RF * ngw) {
        f4_t a[RF][4]; float ss[RF];
#pragma unroll
        for (int q = 0; q < RF; ++q) { const f4_t* xq = (const f4_t*)(P.x + (size_t)(r + q) * DM);
#pragma unroll
            for (int j = 0; j < 4; ++j) a[q][j] = __builtin_nontemporal_load(&xq[j * 64 + lane]); }
#pragma unroll
        for (int q = 0; q < RF; ++q) { float t = 0.f;
#pragma unroll
            for (int j = 0; j < 4; ++j) t += (a[q][j][0] * a[q][j][0] + a[q][j][1] * a[q][j][1]) + (a[q][j][2] * a[q][j][2] + a[q][j][3] * a[q][j][3]);
            ss[q] = wave_sum(t); }
#pragma unroll
        for (int q = 0; q < RF; ++q) { const float rs = rsqrtf(ss[q] * (1.f / DM) + RMS_EPS);
#pragma unroll
            for (int j = 0; j < 4; ++j) { const f4_t g = ((const f4_t*)P.norm_pre)[j * 64 + lane];
                const f2_t p0 = {a[q][j][0] * rs * g[0], a[q][j][1] * rs * g[1]}, p1 = {a[q][j][2] * rs * g[2], a[q][j][3] * rs * g[3]};
                u2_t w; w.x = __builtin_bit_cast(unsigned, __builtin_convertvector(p0, b2_t)); w.y = __builtin_bit_cast(unsigned, __builtin_convertvector(p1, b2_t));
                *(u2_t*)(U + (size_t)(r + q) * DM + (j * 64 + lane) * 4) = w; } }
    }
}

namespace pg8 {
#define PG8_LAS __attribute__((address_space(3)))
typedef unsigned short bf16_t;
typedef short bf16x8 __attribute__((ext_vector_type(8)));
typedef float f32x4 __attribute__((ext_vector_type(4)));
typedef unsigned u32x4 __attribute__((ext_vector_type(4)));
constexpr int BM = 256, BK = 64, HALF = 128, HTB = HALF * BK * 2  , STAGE_BYTES = 8 * HTB, NXCD = 8, WGM = 8;

__host__ __device__ __forceinline__ int lds_byte(int r, int c) { const int st = (r >> 4) * 2 + (c >> 5), rr = r & 15, cc = c & 31, ob = rr * 64 + cc * 2; return st * 1024 + (ob ^ (((ob >> 9) & 1) << 5)); }
__host__ __device__ __forceinline__ void stage_rc(int b, int& R, int& C) { const int st = b / 1024, sb = b % 1024, swz = sb ^ (((sb >> 9) & 1) << 5); R = (st >> 1) * 16 + swz / 64; C = (st & 1) * 32 + (swz % 64) / 2; }
__host__ __device__ __forceinline__ int perm32(int rho) { const int n = rho >> 4, i = rho & 15; return 8 * (i >> 2) + 4 * n + (i & 3); }

struct Unit { int pm, pn; };
struct Gemm { const bf16_t* A; const bf16_t* Bt; int M, N, K; };

struct StaticOrder {
    int nM, nN, nwg, G, c, i0, i1;
    __host__ __device__ void init(int M, int N, int G_, int c_) { nM = M / BM; nN = N / BM; nwg = nM * nN; G = G_; c = c_; i0 = 0; i1 = 1 << 30; }
    __host__ __device__ bool next(int i, Unit& u) const {
        i += i0; if (i >= i1) return false;
        const long L = (long)i * G + c; if (L >= nwg) return false;
        int wgid = (int)L; { const int q = nwg / NXCD, r = nwg % NXCD, xcd = wgid % NXCD, off = wgid / NXCD; wgid = (xcd < r ? xcd * (q + 1) : r * (q + 1) + (xcd - r) * q) + off; }
        const int nig = WGM * nN, gid = wgid / nig, fm = gid * WGM, gsz = (nM - fm) < WGM ? (nM - fm) : WGM;
        u.pm = fm + ((wgid % nig) % gsz); u.pn = (wgid % nig) / gsz; return true;
    }
    __device__ __forceinline__ void a_ready(const Unit&) const {}
    __device__ __forceinline__ void done(const Unit&) const {}
};

typedef float f32x2 __attribute__((ext_vector_type(2)));
typedef __bf16 bf16x2v __attribute__((ext_vector_type(2)));
__device__ __forceinline__ unsigned cvt_pk_bf16(float lo, float hi) { const f32x2 v = {lo, hi}; return __builtin_bit_cast(unsigned, __builtin_convertvector(v, bf16x2v)); }

__device__ __forceinline__ float silu_f(float x) { return x * __builtin_amdgcn_rcpf(1.f + __builtin_amdgcn_exp2f(-1.4426950408889634f * x)); }
__device__ __forceinline__ float sigm_f(float x) { return __builtin_amdgcn_rcpf(1.f + __builtin_amdgcn_exp2f(-1.4426950408889634f * x)); }
__device__ __forceinline__ float bflo(unsigned w) { return __uint_as_float(w << 16); }
__device__ __forceinline__ float bfhi(unsigned w) { return __uint_as_float(w & 0xffff0000u); }
constexpr int EM = 65536;
constexpr float EC2 = 0.125f * 1.4426950408889634f;
struct EpiProj {
    static constexpr bool PAIR = true, PERM = true, AFTER_DRAIN = false, MIDK = false, NEEDS_LDS = false;
    bf16_t* ATT; bf16_t* Z; bf16_t* MRG; float* G;
    static constexpr int NST = 16;
    __device__ __forceinline__ bool relax(const Unit& u, int wc) const { return u.pn < 15 || (u.pn == 23 && wc == 0); }
    template <int KIND> __device__ __forceinline__ void tile(const f32x4 (&acc)[2][2][4][2], bf16_t* base, float sc, int row0, int wc, int fq, int par) const {
#pragma unroll
        for (int ai = 0; ai < 2; ++ai)
#pragma unroll
            for (int m = 0; m < 4; ++m) { const int row = row0 + ai * HALF + m * 16; u32x4 w[2];
#pragma unroll
                for (int bj = 0; bj < 2; ++bj) { f32x4 v0 = acc[ai][bj][m][0], v1 = acc[ai][bj][m][1];
                    if (KIND == 0) { v0 = v0 * sc; v1 = v1 * sc; }
                    if (KIND == 1) { for (int j = 0; j < 4; ++j) { v0[j] = silu_f(v0[j]); v1[j] = silu_f(v1[j]); } }
                    w[bj].x = cvt_pk_bf16(v0[0], v0[1]); w[bj].y = cvt_pk_bf16(v0[2], v0[3]); w[bj].z = cvt_pk_bf16(v1[0], v1[1]); w[bj].w = cvt_pk_bf16(v1[2], v1[3]); }
                u32x4 s1, s2;
#pragma unroll
                for (int e = 0; e < 4; ++e) { const unsigned snd = par ? w[0][e] : w[1][e];
                    const unsigned rcv = (unsigned)__builtin_amdgcn_update_dpp(0, (int)snd, 0xB1, 0xf, 0xf, false);
                    s1[e] = par ? rcv : w[0][e]; s2[e] = par ? w[1][e] : rcv; }
                bf16_t* p = base + ((size_t)wc * EM + (row - par)) * 64 + par * 32 + 8 * fq;
                *(u32x4*)p = s1; *(u32x4*)(p + 64) = s2; }
    }
    __device__ __forceinline__ void operator()(const f32x4 (&acc)[2][2][4][2], const Unit& u, int wr, int wc, int fr, int fq) const {
        const int pn = u.pn, row0 = u.pm * BM + wr * 64 + fr, cl0 = wc * 32 + 8 * fq, par = fr & 1; const size_t HS = (size_t)EM * 64;
        if (pn < 5) tile<0>(acc, ATT + (size_t)(pn * 4) * HS, pn < 2 ? EC2 : 1.f, row0, wc, fq, par);
        else if (pn < 7) tile<1>(acc, Z + (size_t)((pn - 5) * 4) * HS, 1.f, row0, wc, fq, par);
        else if (pn < 13) tile<0>(acc, ATT + (size_t)(20 + (pn - 7) * 4) * HS, pn < 9 ? EC2 : 1.f, row0, wc, fq, par);
        else if (pn < 15) tile<1>(acc, Z + (size_t)(8 + (pn - 13) * 4) * HS, 1.f, row0, wc, fq, par);
        else if (pn < 23) {
#pragma unroll
            for (int ai = 0; ai < 2; ++ai)
#pragma unroll
                for (int m = 0; m < 4; ++m) { const int row = row0 + ai * HALF + m * 16; const int ch = (pn - 15) * 128 + cl0;
                    f32x4 a0 = acc[ai][0][m][0], a1 = acc[ai][0][m][1], b0 = acc[ai][1][m][0], b1 = acc[ai][1][m][1];
                    unsigned qa[8], qb[8];
                    for (int j = 0; j < 4; ++j) { qa[j] = (unsigned)__builtin_rintf(sigm_f(a0[j]) * 255.f); qa[4 + j] = (unsigned)__builtin_rintf(sigm_f(a1[j]) * 255.f);
                        qb[j] = (unsigned)__builtin_rintf(sigm_f(b0[j]) * 255.f); qb[4 + j] = (unsigned)__builtin_rintf(sigm_f(b1[j]) * 255.f); qb[j] = qb[j] < 1u ? 1u : qb[j]; qb[4 + j] = qb[4 + j] < 1u ? 1u : qb[4 + j]; }
                    u32x4 wq; wq.x = qa[0] | (qa[1] << 8) | (qa[2] << 16) | (qa[3] << 24); wq.y = qa[4] | (qa[5] << 8) | (qa[6] << 16) | (qa[7] << 24);
                    wq.z = qb[0] | (qb[1] << 8) | (qb[2] << 16) | (qb[3] << 24); wq.w = qb[4] | (qb[5] << 8) | (qb[6] << 16) | (qb[7] << 24);
                    *(u32x4*)((unsigned char*)MRG + ((size_t)(ch >> 5) * EM + row) * 64 + 2 * (ch & 31)) = wq; }
        }
        else if (wc == 0 && fq < 3) {
#pragma unroll
            for (int ai = 0; ai < 2; ++ai)
#pragma unroll
                for (int m = 0; m < 4; ++m) { const int row = row0 + ai * HALF + m * 16; f32x4 v0 = acc[ai][0][m][0], v1 = acc[ai][0][m][1];
                    for (int j = 0; j < 4; ++j) { v0[j] = sigm_f(v0[j]); v1[j] = sigm_f(v1[j]); }
                    float* p = G + (size_t)row * 24 + 8 * fq; *(f32x4*)p = v0; *(f32x4*)(p + 4) = v1; }
        }
    }
};
struct EpiMG {
    static constexpr bool PAIR = true, PERM = true, AFTER_DRAIN = false, MIDK = true, NEEDS_LDS = false;
    const bf16_t* MRG; bf16_t* MM;
    static constexpr int NST = 0;
    __device__ __forceinline__ bool relax(const Unit&, int) const { return false; }
    __device__ __forceinline__ void mid(f32x4 (&acc)[2][2][4][2], const Unit& u, int wr, int wc, int, int) const {
        const int l_ = lane_id_opaque(), fr = l_ & 15, fq = l_ >> 4;
        const int row0 = u.pm * BM + wr * 64 + fr, grp0 = u.pn * 8 + wc * 2;
        u32x4 q[2][4][2];
#pragma unroll
        for (int ai = 0; ai < 2; ++ai)
#pragma unroll
            for (int m = 0; m < 4; ++m)
#pragma unroll
                for (int bj = 0; bj < 2; ++bj) q[ai][m][bj] = *(const u32x4*)((const unsigned char*)MRG + ((size_t)(grp0 + bj) * EM + row0 + ai * HALF + m * 16) * 64 + 16 * fq);
        asm volatile("" ::: "memory");
#pragma unroll
        for (int ai = 0; ai < 2; ++ai)
#pragma unroll
            for (int m = 0; m < 4; ++m)
#pragma unroll
                for (int bj = 0; bj < 2; ++bj) { const u32x4 g = q[ai][m][bj]; f32x4& v0 = acc[ai][bj][m][0]; f32x4& v1 = acc[ai][bj][m][1];
#pragma unroll
                    for (int j = 0; j < 4; ++j) { v0[j] *= (float)((g.x >> (8 * j)) & 255u) * __builtin_amdgcn_rcpf((float)((g.z >> (8 * j)) & 255u));
                                                  v1[j] *= (float)((g.y >> (8 * j)) & 255u) * __builtin_amdgcn_rcpf((float)((g.w >> (8 * j)) & 255u)); } }
    }
    __device__ __forceinline__ void operator()(const f32x4 (&acc)[2][2][4][2], const Unit& u, int wr, int wc, int fr, int fq) const {
        const int par = fr & 1, row0 = u.pm * BM + wr * 64 + fr, grp0 = u.pn * 8 + wc * 2;
        uint2 sg[2][4][2];
#pragma unroll
        for (int ai = 0; ai < 2; ++ai)
#pragma unroll
            for (int m = 0; m < 4; ++m)
#pragma unroll
                for (int bj = 0; bj < 2; ++bj) sg[ai][m][bj] = *(const uint2*)((const unsigned char*)MRG + ((size_t)(grp0 + bj) * EM + row0 + ai * HALF + m * 16) * 64 + 16 * fq + 8);
        asm volatile("" ::: "memory");
#pragma unroll
        for (int ai = 0; ai < 2; ++ai)
#pragma unroll
            for (int m = 0; m < 4; ++m) { const int row = row0 + ai * HALF + m * 16; u32x4 w[2];
#pragma unroll
                for (int bj = 0; bj < 2; ++bj) { const uint2 s = sg[ai][m][bj];
                    const f32x4 a0 = acc[ai][bj][m][0], a1 = acc[ai][bj][m][1]; constexpr float Q = 1.f / 255.f;
                    w[bj].x = cvt_pk_bf16(a0[0] * ((float)(s.x & 255u) * Q), a0[1] * ((float)((s.x >> 8) & 255u) * Q)); w[bj].y = cvt_pk_bf16(a0[2] * ((float)((s.x >> 16) & 255u) * Q), a0[3] * ((float)(s.x >> 24) * Q));
                    w[bj].z = cvt_pk_bf16(a1[0] * ((float)(s.y & 255u) * Q), a1[1] * ((float)((s.y >> 8) & 255u) * Q)); w[bj].w = cvt_pk_bf16(a1[2] * ((float)((s.y >> 16) & 255u) * Q), a1[3] * ((float)(s.y >> 24) * Q)); }
                u32x4 s1, s2;
#pragma unroll
                for (int e = 0; e < 4; ++e) { const unsigned snd = par ? w[0][e] : w[1][e];
                    const unsigned rcv = (unsigned)__builtin_amdgcn_update_dpp(0, (int)snd, 0xB1, 0xf, 0xf, false);
                    s1[e] = par ? rcv : w[0][e]; s2[e] = par ? w[1][e] : rcv; }
                bf16_t* p = MM + (size_t)(row - par) * 1024 + u.pn * BM + wc * 64 + par * 32 + 8 * fq;
                *(u32x4*)p = s1; *(u32x4*)(p + 1024) = s2; }
    }
};
struct EpiOut {
    static constexpr bool PAIR = false, PERM = true, AFTER_DRAIN = false, MIDK = false, NEEDS_LDS = false;
    bf16_t* T; float* SS;
    static constexpr int NST = 24;
    __device__ __forceinline__ bool relax(const Unit&, int) const { return true; }
    __device__ __forceinline__ void operator()(const f32x4 (&acc)[2][2][4][2], const Unit& u, int wr, int wc, int fr, int fq) const {
        const int row0 = u.pm * BM + wr * 64 + fr, col0 = u.pn * BM + wc * 32 + 8 * fq;
#pragma unroll
        for (int ai = 0; ai < 2; ++ai)
#pragma unroll
            for (int m = 0; m < 4; ++m) { const int row = row0 + ai * HALF + m * 16; float s = 0.f;
#pragma unroll
                for (int bj = 0; bj < 2; ++bj) { const int col = col0 + bj * HALF; const f32x4 v0 = acc[ai][bj][m][0], v1 = acc[ai][bj][m][1];
                    s += (v0[0] * v0[0] + v0[1] * v0[1]) + (v0[2] * v0[2] + v0[3] * v0[3]) + (v1[0] * v1[0] + v1[1] * v1[1]) + (v1[2] * v1[2] + v1[3] * v1[3]);
                    u32x4 w; w.x = cvt_pk_bf16(v0[0], v0[1]); w.y = cvt_pk_bf16(v0[2], v0[3]); w.z = cvt_pk_bf16(v1[0], v1[1]); w.w = cvt_pk_bf16(v1[2], v1[3]);
                    *(u32x4*)(T + (size_t)row * 1024 + col) = w; }
                s += __shfl_xor(s, 16); s += __shfl_xor(s, 32);
                if (fq == 0) SS[(size_t)(u.pn * 4 + wc) * EM + row] = s; }
    }
};

struct EpiFinal {
    static constexpr bool PAIR = false, PERM = true, AFTER_DRAIN = false, MIDK = false, NEEDS_LDS = true;
    static constexpr int NST = 16;
    const float* X; const float* Gn; float* OUT; float* SSP; unsigned* CNT;
    __device__ __forceinline__ bool relax(const Unit&, int) const { return true; }
    __device__ __forceinline__ void run(const f32x4 (&acc)[2][2][4][2], const Unit& u, int wr, int wc, int fr, int fq, PG8_LAS unsigned char* xl, int tid) const {
        typedef float f4v __attribute__((ext_vector_type(4)));
        PG8_LAS float* red = (PG8_LAS float*)xl; PG8_LAS float* rsl = red + 1024;
#pragma unroll
        for (int ai = 0; ai < 2; ++ai)
#pragma unroll
            for (int m = 0; m < 4; ++m) { float s = 0.f;
#pragma unroll
                for (int bj = 0; bj < 2; ++bj) { const f32x4 v0 = acc[ai][bj][m][0], v1 = acc[ai][bj][m][1];
                    s += (v0[0] * v0[0] + v0[1] * v0[1]) + (v0[2] * v0[2] + v0[3] * v0[3]) + (v1[0] * v1[0] + v1[1] * v1[1]) + (v1[2] * v1[2] + v1[3] * v1[3]); }
                s += __shfl_xor(s, 16); s += __shfl_xor(s, 32);
                if (fq == 0) red[wc * 256 + ai * HALF + wr * 64 + m * 16 + fr] = s; }
        asm volatile("s_waitcnt lgkmcnt(0)" ::: "memory"); __builtin_amdgcn_s_barrier();
        if (tid < 256) { const float p = (red[tid] + red[256 + tid]) + (red[512 + tid] + red[768 + tid]);
            __hip_atomic_store(SSP + (size_t)u.pn * EM + u.pm * BM + tid, p, __ATOMIC_RELAXED, __HIP_MEMORY_SCOPE_AGENT); }
        asm volatile("s_waitcnt vmcnt(0)" ::: "memory"); __builtin_amdgcn_s_barrier();
        if (tid == 0) { __hip_atomic_fetch_add(CNT + u.pm, 1u, __ATOMIC_RELAXED, __HIP_MEMORY_SCOPE_AGENT);
            while (__hip_atomic_load(CNT + u.pm, __ATOMIC_RELAXED, __HIP_MEMORY_SCOPE_AGENT) < 4u) __builtin_amdgcn_s_sleep(1); }
        __builtin_amdgcn_s_barrier();
        if (tid < 256) { float ss = 0.f;
#pragma unroll
            for (int q = 0; q < 4; ++q) ss += __hip_atomic_load(SSP + (size_t)q * EM + u.pm * BM + tid, __ATOMIC_RELAXED, __HIP_MEMORY_SCOPE_AGENT);
            rsl[tid] = rsqrtf(ss * (1.f / 1024.f) + 1e-6f); }
        asm volatile("s_waitcnt lgkmcnt(0)" ::: "memory"); __builtin_amdgcn_s_barrier();
        const int par = fr & 1, row0 = u.pm * BM + wr * 64 + fr - par, col0 = u.pn * BM + wc * 32, gcol = col0 + 8 * fq, pc = 4 * (2 * fq + par);
        f4v xq[2][2][2][2];
#define EF_LOAD(B_, Q_) do { _Pragma("unroll") for (int m2 = 0; m2 < 2; ++m2) _Pragma("unroll") for (int bj = 0; bj < 2; ++bj) { \
            const float* xp = X + (size_t)(row0 + ((Q_) >> 1) * HALF + (((Q_) & 1) * 2 + m2) * 16) * 1024 + col0 + bj * HALF + pc; \
            xq[B_][m2][bj][0] = __builtin_nontemporal_load((const f4v*)xp); xq[B_][m2][bj][1] = __builtin_nontemporal_load((const f4v*)(xp + 1024)); } } while (0)
#define EF_PROC(B_, Q_) do { _Pragma("unroll") for (int m2 = 0; m2 < 2; ++m2) { constexpr int ai = (Q_) >> 1, m = ((Q_) & 1) * 2; const float rs = rsl[ai * HALF + wr * 64 + (m + m2) * 16 + fr]; \
            _Pragma("unroll") for (int bj = 0; bj < 2; ++bj) { const int col = gcol + bj * HALF; const f4v g0 = *(const f4v*)(Gn + col), g1 = *(const f4v*)(Gn + col + 4); \
                const f32x4 v0 = acc[ai][bj][m + m2][0], v1 = acc[ai][bj][m + m2][1]; f4v o0, o1; \
                _Pragma("unroll") for (int e = 0; e < 4; ++e) { const float t0 = v0[e] * rs * g0[e], t1 = v1[e] * rs * g1[e]; const float snd = par ? t0 : t1; \
                    const float rcv = __int_as_float(__builtin_amdgcn_update_dpp(0, __float_as_int(snd), 0xB1, 0xf, 0xf, false)); \
                    o0[e] = xq[B_][m2][bj][0][e] + (par ? rcv : t0); o1[e] = xq[B_][m2][bj][1][e] + (par ? t1 : rcv); } \
                float* op = OUT + (size_t)(row0 + ai * HALF + (m + m2) * 16) * 1024 + col0 + bj * HALF + pc; \
                __builtin_nontemporal_store(o0, (f4v*)op); __builtin_nontemporal_store(o1, (f4v*)(op + 1024)); } } } while (0)
        EF_LOAD(0, 0); EF_LOAD(1, 1);
        EF_PROC(0, 0); EF_LOAD(0, 2);
        EF_PROC(1, 1); EF_LOAD(1, 3);
        EF_PROC(0, 2); EF_PROC(1, 3);
#undef EF_LOAD
#undef EF_PROC
    }
};

template <class Epi, class Sched, bool ALIGN_EPI = false, bool SP2 = false>
__device__ __forceinline__ void gemm_phase(PG8_LAS unsigned char* lds, const Gemm g, const Sched& S, const Epi& E, const int wid) {
    const int lane = lane_id(), tid = ((wid & 7) << 6) | lane, wr = (wid >> 2) & 1, wc = wid & 3, fr = lane & 15, fq = lane >> 4;
    const int K = g.K, nt = K / BK;
    unsigned voffA[2], voffB[2];
#pragma unroll
    for (int i = 0; i < 2; ++i) { int R, C; stage_rc(tid * 16 + i * 8192, R, C); const int Rb = Epi::PAIR ? ((R >> 5) * 64 + perm32(R & 31)) : Epi::PERM ? ((R & ~31) + perm32(R & 31)) : R;
        voffA[i] = (unsigned)(R * K + C) * 2u; voffB[i] = (unsigned)(Rb * K + C) * 2u; }
    const size_t kstep = (size_t)(BK * 2);
    const size_t hstep = (size_t)HALF * K * 2;
    const size_t hstepB = Epi::PAIR ? (size_t)32 * K * 2 : hstep;
    const size_t tstep = 2 * hstep;
    const unsigned ldsw = (unsigned)wid * 1024u;
    const int aoff = lds_byte(wr * 64 + fr, fq * 8), boff = lds_byte(wc * 32 + fr, fq * 8);
#define PG8_SA(b, h) (((b) * 2 + (h)) * HTB)
#define PG8_SB(b, h) ((4 + (b) * 2 + (h)) * HTB)
#define PG8_STAGE(bufoff, gbase, voff) do { _Pragma("unroll") for (int _i = 0; _i < 2; ++_i) \
        __builtin_amdgcn_global_load_lds((const unsigned*)((const char*)(gbase) + (voff)[_i]), (PG8_LAS unsigned*)(lds + (bufoff) + ldsw + _i * 8192), 16, 0, 0); } while (0)
#define PG8_LDA(dst, b, h) do { _Pragma("unroll") for (int m = 0; m < 4; ++m) _Pragma("unroll") for (int k = 0; k < 2; ++k) dst[m][k] = *(const PG8_LAS bf16x8*)(lds + PG8_SA(b, h) + aoff + m * 2048 + k * 1024); } while (0)
#define PG8_LDB(dst, b, h) do { _Pragma("unroll") for (int n = 0; n < 2; ++n) _Pragma("unroll") for (int k = 0; k < 2; ++k) dst[n][k] = *(const PG8_LAS bf16x8*)(lds + PG8_SB(b, h) + boff + n * 2048 + k * 1024); } while (0)
#define PG8_MMA(ai, bj, At, Bt) do { __builtin_amdgcn_s_setprio(1); _Pragma("unroll") for (int m = 0; m < 4; ++m) _Pragma("unroll") for (int n = 0; n < 2; ++n) _Pragma("unroll") for (int k = 0; k < 2; ++k) \
        acc[ai][bj][m][n] = __builtin_amdgcn_mfma_f32_16x16x32_bf16(Bt[n][k], At[m][k], acc[ai][bj][m][n], 0, 0, 0); __builtin_amdgcn_s_setprio(0); } while (0)
#define PG8_WAIT_V(n) asm volatile("s_waitcnt vmcnt(" #n ")" ::: "memory")
#define PG8_WAIT_L(n) asm volatile("s_waitcnt lgkmcnt(" #n ")" ::: "memory")
#define PG8_BAR __builtin_amdgcn_s_barrier()
#define PG8_SCHED __builtin_amdgcn_sched_barrier(0)
#define PG8_KT2(WV3, A11) do { \
            PG8_LDB(B0, 0, 0); PG8_LDB(B1, 0, 1); PG8_SCHED; PG8_LDA(At, 0, 0); if (A11) PG8_STAGE(PG8_SA(1, 1), a1 + hstep, voffA); \
            WV3; PG8_WAIT_L(0); PG8_BAR; PG8_MMA(0, 0, At, B0); PG8_MMA(0, 1, At, B1); PG8_BAR; PG8_SCHED; \
            PG8_LDA(At, 0, 1); PG8_STAGE(PG8_SB(0, 0), b2, voffB); PG8_STAGE(PG8_SB(0, 1), b2 + hstepB, voffB); PG8_STAGE(PG8_SA(0, 0), a2, voffA); \
            WV3; PG8_WAIT_L(0); PG8_BAR; PG8_MMA(1, 0, At, B0); PG8_MMA(1, 1, At, B1); PG8_BAR; PG8_SCHED; \
            PG8_LDB(B0, 1, 0); PG8_LDB(B1, 1, 1); PG8_SCHED; PG8_LDA(At, 1, 0); PG8_STAGE(PG8_SA(0, 1), a2 + hstep, voffA); \
            WV3; PG8_WAIT_L(0); PG8_BAR; PG8_MMA(0, 0, At, B0); PG8_MMA(0, 1, At, B1); PG8_BAR; PG8_SCHED; \
            PG8_LDA(At, 1, 1); PG8_STAGE(PG8_SB(1, 0), b3, voffB); PG8_STAGE(PG8_SB(1, 1), b3 + hstepB, voffB); PG8_STAGE(PG8_SA(1, 0), a3, voffA); \
            PG8_WAIT_V(8); PG8_WAIT_L(0); PG8_BAR; PG8_MMA(1, 0, At, B0); PG8_MMA(1, 1, At, B1); PG8_BAR; PG8_SCHED; } while (0)
    Unit cur, nxt; int ui = 0; bool rx = false;
    if (!S.next(0, cur)) return;
    f32x4 acc[2][2][4][2];
#pragma unroll
    for (int a = 0; a < 2; ++a)
#pragma unroll
        for (int b = 0; b < 2; ++b)
#pragma unroll
            for (int m = 0; m < 4; ++m)
#pragma unroll
                for (int n = 0; n < 2; ++n) { acc[a][b][m][n] = (f32x4){0.f, 0.f, 0.f, 0.f}; asm volatile("" : "+v"(acc[a][b][m][n])); }
    bf16x8 At[4][2], B0[2][2], B1[2][2];
    const char* cA = (const char*)g.A + (size_t)cur.pm * tstep; const char* cB = (const char*)g.Bt + (size_t)cur.pn * tstep;
    S.a_ready(cur);
    if constexpr (SP2) {
        PG8_STAGE(PG8_SB(0, 0), cB, voffB); PG8_STAGE(PG8_SB(0, 1), cB + hstepB, voffB); PG8_STAGE(PG8_SA(0, 0), cA, voffA); PG8_STAGE(PG8_SA(0, 1), cA + hstep, voffA);
        if (wr == 1) PG8_BAR;
        PG8_WAIT_V(2); PG8_BAR;
        PG8_STAGE(PG8_SB(1, 0), cB + kstep, voffB); PG8_STAGE(PG8_SA(1, 0), cA + kstep, voffA); PG8_STAGE(PG8_SB(1, 1), cB + hstepB + kstep, voffB);
        PG8_WAIT_V(6); PG8_BAR;
    } else {
        PG8_STAGE(PG8_SB(0, 0), cB, voffB); PG8_STAGE(PG8_SA(0, 0), cA, voffA); PG8_STAGE(PG8_SB(0, 1), cB + hstepB, voffB); PG8_STAGE(PG8_SA(0, 1), cA + hstep, voffA);
        if (wr == 1) PG8_BAR;
        PG8_WAIT_V(4); PG8_BAR;
        PG8_STAGE(PG8_SB(1, 0), cB + kstep, voffB); PG8_STAGE(PG8_SA(1, 0), cA + kstep, voffA); PG8_STAGE(PG8_SB(1, 1), cB + hstepB + kstep, voffB);
        PG8_WAIT_V(6); PG8_BAR;
    }
    for (;;) {
        const bool has_next = S.next(ui + 1, nxt);
        const char* nA = has_next ? (const char*)g.A + (size_t)nxt.pm * tstep : cA; const char* nB = has_next ? (const char*)g.Bt + (size_t)nxt.pn * tstep : cB;
        int t0 = 0;
        if constexpr (SP2 && Epi::NST > 0) { if (rx) {
            const char* a1 = cA + kstep; const char* a2 = cA + 2 * kstep; const char* b2 = cB + 2 * kstep; const char* a3 = a2 + kstep; const char* b3 = b2 + kstep;
            if constexpr (Epi::NST == 16) PG8_KT2(PG8_WAIT_V(24), false); else PG8_KT2(PG8_WAIT_V(32), false);
            t0 = 2; rx = false; } }
        for (int t = t0; t < nt; t += 2) {
            if constexpr (Epi::MIDK) { if (t == nt / 2) { __builtin_amdgcn_sched_barrier(0); E.mid(acc, cur, wr, wc, fr, fq); __builtin_amdgcn_sched_barrier(0); } }
            const bool last = (t == nt - 2);
            const char* a1 = cA + (size_t)(t + 1) * kstep;
            const char* a2 = last ? nA : cA + (size_t)(t + 2) * kstep; const char* b2 = last ? nB : cB + (size_t)(t + 2) * kstep;
            const char* a3 = a2 + kstep; const char* b3 = b2 + kstep;
            if (last && has_next) S.a_ready(nxt);
            if constexpr (SP2) {
            PG8_KT2(PG8_WAIT_V(8), true);
            } else {
            PG8_LDB(B0, 0, 0); PG8_SCHED; PG8_LDA(At, 0, 0); PG8_STAGE(PG8_SA(1, 1), a1 + hstep, voffA);
            PG8_WAIT_L(8); PG8_BAR; PG8_WAIT_L(0); PG8_MMA(0, 0, At, B0); PG8_BAR; PG8_SCHED;
            PG8_LDB(B1, 0, 1); PG8_STAGE(PG8_SB(0, 0), b2, voffB);
            PG8_BAR; PG8_WAIT_L(0); PG8_MMA(0, 1, At, B1); PG8_BAR;
            PG8_LDA(At, 0, 1); PG8_STAGE(PG8_SA(0, 0), a2, voffA);
            PG8_BAR; PG8_WAIT_L(0); PG8_MMA(1, 0, At, B0); PG8_BAR; PG8_SCHED;
            PG8_STAGE(PG8_SB(0, 1), b2 + hstepB, voffB);
            PG8_WAIT_V(6); PG8_BAR; PG8_MMA(1, 1, At, B1); PG8_BAR;
            PG8_LDB(B0, 1, 0); PG8_SCHED; PG8_LDA(At, 1, 0); PG8_STAGE(PG8_SA(0, 1), a2 + hstep, voffA);
            PG8_WAIT_L(8); PG8_BAR; PG8_WAIT_L(0); PG8_MMA(0, 0, At, B0); PG8_BAR; PG8_SCHED;
            PG8_LDB(B1, 1, 1); PG8_STAGE(PG8_SB(1, 0), b3, voffB);
            PG8_BAR; PG8_WAIT_L(0); PG8_MMA(0, 1, At, B1); PG8_BAR;
            PG8_LDA(At, 1, 1); PG8_STAGE(PG8_SA(1, 0), a3, voffA);
            PG8_BAR; PG8_WAIT_L(0); PG8_MMA(1, 0, At, B0); PG8_BAR; PG8_SCHED;
            PG8_STAGE(PG8_SB(1, 1), b3 + hstepB, voffB);
            PG8_WAIT_V(6); PG8_BAR; PG8_MMA(1, 1, At, B1); PG8_BAR;
            }
        }
        if constexpr (ALIGN_EPI) { if (wr == 0) PG8_BAR; }
        if constexpr (SP2 && !Epi::AFTER_DRAIN) { if constexpr (Epi::NST > 0) { if (has_next && E.relax(cur, wc)) { PG8_STAGE(PG8_SA(1, 1), nA + kstep + hstep, voffA); rx = true; } } }
        if constexpr (Epi::NEEDS_LDS) { E.run(acc, cur, wr, wc, fr, fq, lds + STAGE_BYTES, tid); S.done(cur); }
        else if constexpr (!Epi::AFTER_DRAIN) { E(acc, cur, wr, wc, fr, fq); S.done(cur); }
        if (!has_next) break;
#pragma unroll
        for (int a = 0; a < 2; ++a)
#pragma unroll
            for (int b = 0; b < 2; ++b)
#pragma unroll
                for (int m = 0; m < 4; ++m)
#pragma unroll
                    for (int n = 0; n < 2; ++n) { acc[a][b][m][n] = (f32x4){0.f, 0.f, 0.f, 0.f}; asm volatile("" : "+v"(acc[a][b][m][n])); }
        cur = nxt; cA = nA; cB = nB; ++ui;
        if constexpr (ALIGN_EPI) { if (wr == 1) PG8_BAR; }
    }
    PG8_WAIT_V(0);
    if constexpr (!ALIGN_EPI) { if (wr == 0) PG8_BAR; }
    PG8_BAR;
    if constexpr (Epi::AFTER_DRAIN) { E.fused(acc, cur, wr, wc, fr, fq, lds, wid, lane); S.done(cur); }
#undef PG8_SA
#undef PG8_SB
#undef PG8_STAGE
#undef PG8_LDA
#undef PG8_LDB
#undef PG8_MMA
#undef PG8_KT2
#undef PG8_WAIT_V
#undef PG8_WAIT_L
#undef PG8_BAR
#undef PG8_SCHED
}
}

DEVI void phase_compress(const Params& P, float* lds, const int wid) {
    const bf16_t* ATT = (const bf16_t*)(P.ws + WS_ATT);
    const int lane = lane_id_opaque(), wv = wid, gw = blockIdx.x * (NT / 64) + wid, ngw = (gridDim.x * NT) >> 6;
    float* hl = lds + wv * 128;
    for (int it = gw; it < 2 * NB * 2 * 256; it += ngw) {
        const int n = it & 255, g = (it >> 8) & 1, b = (it >> 9) & 15, which = it >> 13;
        bf16_t* OUT = (bf16_t*)(P.ws + (which ? WS_VC : WS_KC)) + ((size_t)((b * 2 + g) * 256 + n)) * 64;
        if (n == 255) { OUT[lane] = 0; continue; }
        const float* pe = which ? P.pe_v : P.pe_k; const float* w1 = which ? P.w1_v : P.w1_k; const float* w2 = which ? P.w2_v : P.w2_k;
        const bf16_t* src = ATT + ((size_t)((which ? HC_VCMP : HC_KCMP) + g) * MROWS + (size_t)b * SEQ + n * 16) * 64;
        float h0 = 0.f, h1 = 0.f;
        for (int kk = 0; kk < 2048; ++kk) { const float a = bf2f(src[kk]) + pe[kk]; h0 += a * w1[(size_t)kk * 128 + lane]; h1 += a * w1[(size_t)kk * 128 + 64 + lane]; }
        hl[lane] = siluf_(h0); hl[64 + lane] = siluf_(h1); LDS_SYNC();
        float o = 0.f;
        for (int e = 0; e < 128; ++e) o += hl[e] * w2[e * 64 + lane];
        OUT[lane] = f2bf(o); LDS_SYNC();
    }
    float* KBAR = (float*)(P.ws + WS_KBAR);
    for (int it = gw; it < NB * 8 * 16; it += ngw) {
        const int n = it & 15, h = (it >> 4) & 7, b = it >> 7;
        const bf16_t* src = ATT + ((size_t)(HC_KB + h) * MROWS + (size_t)b * SEQ + n * 256) * 64;
        float s = 0.f;
        for (int r = 0; r < 256; ++r) s += bf2f(src[r * 64 + lane]);
        KBAR[(size_t)it * 64 + lane] = s * (1.f / 256.f);
    }
}

#define NAIVE_NSA 0
#ifndef PROBE_NSA2
#define PROBE_NSA2 0
#endif
#ifndef PROBE_MOBA2
#define PROBE_MOBA2 0
#endif
#define NAIVE_MOBA 0
namespace att {
#define ALAS __attribute__((address_space(3)))
typedef short bf16x8 __attribute__((ext_vector_type(8)));
typedef short s16x4 __attribute__((ext_vector_type(4)));
typedef short v4i16_t __attribute__((ext_vector_type(4)));
typedef float f32x16 __attribute__((ext_vector_type(16)));
typedef float f32x4 __attribute__((ext_vector_type(4)));
typedef unsigned u32x4 __attribute__((ext_vector_type(4)));
typedef unsigned u32x2 __attribute__((ext_vector_type(2)));
typedef float f32x2_t __attribute__((ext_vector_type(2)));
typedef __bf16 bf16x2_t __attribute__((ext_vector_type(2)));
typedef ALAS char lchar;

constexpr float NEG = -1e30f, MFLOOR = -8192.f, THR = 6.f;
constexpr int BIG = 1000000;
constexpr int WAVE_BYTES = 11264;
constexpr int L_K = 0, L_V = 24576, L_OVT = 49152, L_KBT = 65536, L_TL = L_KBT, L_WAVE = 73728, L_WG = L_WAVE + 2688;
constexpr int W_WSF = 0, W_IMP = 512, W_MASK = 2560, W_OT = 3072;
static_assert(L_WAVE + 8 * WAVE_BYTES <= 163840, "attention LDS map");

#define ATT_MFMA(a, b, c) __builtin_amdgcn_mfma_f32_32x32x16_bf16(a, b, c, 0, 0, 0)
#define ATT_LSYNC() asm volatile("s_waitcnt lgkmcnt(0)" ::: "memory")
#define ATT_BAR() do { asm volatile("s_waitcnt lgkmcnt(0)" ::: "memory"); __builtin_amdgcn_s_barrier(); asm volatile("" ::: "memory"); } while (0)

DEVI int crow(int r, int hi) { return (r & 3) + 8 * (r >> 2) + 4 * hi; }
DEVI float max3f(float a, float b, float c) { float r; asm("v_max3_f32 %0, %1, %2, %3" : "=v"(r) : "v"(a), "v"(b), "v"(c)); return r; }
DEVI float max2f(float a, float b) { float r; asm("v_max_f32_e32 %0, %1, %2" : "=v"(r) : "v"(a), "v"(b)); return r; }
DEVI unsigned cvtpk(float lo, float hi) { f32x2_t v = {lo, hi}; bf16x2_t b = __builtin_convertvector(v, bf16x2_t); return __builtin_bit_cast(unsigned, b); }
DEVI s16x4 vtr(const lchar* p) { return __builtin_bit_cast(s16x4, __builtin_amdgcn_ds_read_tr16_b64_v4i16((ALAS v4i16_t*)p)); }
DEVI float swap_other(float x, int hi) { auto rr = __builtin_amdgcn_permlane32_swap(__float_as_uint(x), __float_as_uint(x), false, false); return __uint_as_float(hi ? rr[0] : rr[1]); }
DEVI float swap_max(float x) { auto rr = __builtin_amdgcn_permlane32_swap(__float_as_uint(x), __float_as_uint(x), false, false); return fmaxf(__uint_as_float(rr[0]), __uint_as_float(rr[1])); }
DEVI float swap_sum(float x) { auto rr = __builtin_amdgcn_permlane32_swap(__float_as_uint(x), __float_as_uint(x), false, false); return __uint_as_float(rr[0]) + __uint_as_float(rr[1]); }

struct Stage { u32x4 k, v; };
DEVI void stage_load(Stage& s, const bf16_t* Kblk, const bf16_t* Vblk, int wid, int lane) {
    s.k = *(const u32x4*)(Kblk + lane * 64 + wid * 8);
    s.v = *(const u32x4*)(Vblk + (16 * (wid & 3) + (lane >> 2)) * 64 + (wid >> 2) * 32 + (lane & 3) * 8);
}
DEVI void stage_write(const Stage& s, lchar* Kb, lchar* Vb, int wid, int lane) {
    *(ALAS u32x4*)(Kb + wid * 1024 + lane * 16) = s.k;
    *(ALAS u32x4*)(Vb + wid * 1024 + lane * 16) = s.v;
}

template <int NO, bool EMASK>
DEVI void flash_block(const lchar* Kb, const lchar* Vb, const lchar* OVb, const bf16x8 (&qr)[4], f32x16 (&o)[NO], float& m, float& l, const bool first,
                      const float cbase, const float kslope, const int lim_lo, const int lim_hi, ALAS float* wsf, const int lane) {
    const int r32 = lane & 31, hi = lane >> 5;
    const float cb = first ? cbase : cbase - m;
    f32x16 p0, p1;
#pragma unroll
    for (int r = 0; r < 16; ++r) { const float lit = (float)((r & 3) + 8 * (r >> 2)); p0[r] = __builtin_fmaf(kslope, lit, cb); p1[r] = __builtin_fmaf(kslope, lit + 32.f, cb); }
    const lchar* kb = Kb + hi * 1024 + r32 * 16;
    __builtin_amdgcn_s_setprio(1);
#pragma unroll
    for (int d0 = 0; d0 < 4; ++d0) {
        const bf16x8 b0 = *(const ALAS bf16x8*)(kb + d0 * 2048), b1 = *(const ALAS bf16x8*)(kb + d0 * 2048 + 512);
        p0 = ATT_MFMA(b0, qr[d0], p0); p1 = ATT_MFMA(b1, qr[d0], p1);
        if (NO > 2 && (d0 & 1)) __builtin_amdgcn_sched_barrier(0);
    }
    __builtin_amdgcn_s_setprio(0);
    const int va = ((lane >> 4) & 1) * 32 + (lane & 3) * 8 + (4 * hi + ((lane & 15) >> 2)) * 64;
    bf16x8 vfr[1][4];
    if (NO == 2) {
#pragma unroll
        for (int d = 0; d < 1; ++d) {
            const lchar* vb = Vb + d * 4096 + va;
#pragma unroll
            for (int ks = 0; ks < 4; ++ks) { const s16x4 lo4 = vtr(vb + ks * 1024), hi4 = vtr(vb + ks * 1024 + 512);
                vfr[d][ks] = (bf16x8){lo4[0], lo4[1], lo4[2], lo4[3], hi4[0], hi4[1], hi4[2], hi4[3]}; }
        }
        __builtin_amdgcn_sched_barrier(0);
    }
    if (EMASK) {
        const int lo_ = lim_lo - 4 * hi, hi_ = lim_hi - 4 * hi;
#pragma unroll
        for (int r = 0; r < 16; ++r) { const int lit = (r & 3) + 8 * (r >> 2);
            p0[r] = (lit >= lo_ && lit <= hi_) ? p0[r] : NEG; p1[r] = (lit + 32 >= lo_ && lit + 32 <= hi_) ? p1[r] : NEG; }
    }
    float rm, rm2;
    { rm = max3f(p0[0], p0[1], p1[0]); rm2 = max3f(p0[2], p0[3], p1[1]); rm = max3f(rm, p1[2], p1[3]);
#pragma unroll
      for (int r = 4; r < 16; r += 4) { rm = max3f(rm, p0[r], p0[r + 1]); rm2 = max3f(rm2, p0[r + 2], p0[r + 3]); rm = max3f(rm, p1[r], p1[r + 1]); rm2 = max3f(rm2, p1[r + 2], p1[r + 3]); }
      rm = max2f(rm, rm2); }
    { auto rr = __builtin_amdgcn_permlane32_swap(__float_as_uint(rm), __float_as_uint(rm), false, false); rm = max2f(__uint_as_float(rr[0]), __uint_as_float(rr[1])); }
    float dl = 0.f; bool sub;
    if (first) { m = max2f(rm, MFLOOR); dl = m; sub = true; }
    else {
        sub = __any(rm > THR);
        if (sub) {
            dl = max2f(rm, 0.f); m += dl;
            const float alpha = __builtin_amdgcn_exp2f(-dl); l *= alpha;
            wsf[r32] = alpha; ATT_LSYNC();
#pragma unroll
            for (int r = 0; r < 16; ++r) { const float a = wsf[crow(r, hi)];
#pragma unroll
                for (int d = 0; d < NO; ++d) o[d][r] *= a; }
            ATT_LSYNC();
        }
    }
    if (sub) {
#pragma unroll
        for (int r = 0; r < 16; ++r) { p0[r] -= dl; p1[r] -= dl; }
    }
    float s = 0.f;
#pragma unroll
    for (int r = 0; r < 16; ++r) { p0[r] = __builtin_amdgcn_exp2f(p0[r]); p1[r] = __builtin_amdgcn_exp2f(p1[r]); s += p0[r] + p1[r]; }
    l += s;
    u32x4 pw[4];
    pw[0] = (u32x4){cvtpk(p0[0], p0[1]), cvtpk(p0[2], p0[3]), cvtpk(p0[4], p0[5]), cvtpk(p0[6], p0[7])};
    pw[1] = (u32x4){cvtpk(p0[8], p0[9]), cvtpk(p0[10], p0[11]), cvtpk(p0[12], p0[13]), cvtpk(p0[14], p0[15])};
    pw[2] = (u32x4){cvtpk(p1[0], p1[1]), cvtpk(p1[2], p1[3]), cvtpk(p1[4], p1[5]), cvtpk(p1[6], p1[7])};
    pw[3] = (u32x4){cvtpk(p1[8], p1[9]), cvtpk(p1[10], p1[11]), cvtpk(p1[12], p1[13]), cvtpk(p1[14], p1[15])};
    if (NO == 2) {
        bf16x8 vf1[4];
#pragma unroll
        for (int ks = 0; ks < 4; ++ks) { const lchar* vb = Vb + 4096 + va; const s16x4 lo4 = vtr(vb + ks * 1024), hi4 = vtr(vb + ks * 1024 + 512);
            vf1[ks] = (bf16x8){lo4[0], lo4[1], lo4[2], lo4[3], hi4[0], hi4[1], hi4[2], hi4[3]}; }
        __builtin_amdgcn_s_setprio(1);
#pragma unroll
        for (int ks = 0; ks < 4; ++ks) o[0] = ATT_MFMA(__builtin_bit_cast(bf16x8, pw[ks]), vfr[0][ks], o[0]);
#pragma unroll
        for (int ks = 0; ks < 4; ++ks) o[1] = ATT_MFMA(__builtin_bit_cast(bf16x8, pw[ks]), vf1[ks], o[1]);
        __builtin_amdgcn_s_setprio(0);
    } else {
#pragma unroll
        for (int d = 0; d < NO; ++d) {
            const lchar* vb = (d < 2 ? Vb + d * 4096 : OVb + (d - 2) * 4096) + va;
#pragma unroll
            for (int ks = 0; ks < 4; ++ks) {
                const s16x4 lo4 = vtr(vb + ks * 1024), hi4 = vtr(vb + ks * 1024 + 512);
                const bf16x8 vf = {lo4[0], lo4[1], lo4[2], lo4[3], hi4[0], hi4[1], hi4[2], hi4[3]};
                o[d] = ATT_MFMA(__builtin_bit_cast(bf16x8, pw[ks]), vf, o[d]);
            }
            __builtin_amdgcn_sched_barrier(0);
        }
    }
}


DEVI void glds16s(const void* sbase, unsigned voff, unsigned lds_dst) { unsigned keep;
    asm volatile("s_mov_b32 %0, m0\n\ts_mov_b32 m0, %3\n\ts_nop 0\n\tglobal_load_lds_dwordx4 %1, %2\n\ts_mov_b32 m0, %0" : "=&s"(keep) : "v"(voff), "s"(sbase), "s"(lds_dst) : "memory"); }
DEVI void glds16(const void* gsrc, unsigned lds_dst) { unsigned keep;
    asm volatile("s_mov_b32 %0, m0\n\ts_mov_b32 m0, %2\n\ts_nop 0\n\tglobal_load_lds_dwordx4 %1, off\n\ts_mov_b32 m0, %0" : "=&s"(keep) : "v"(gsrc), "s"(lds_dst) : "memory"); }
#define ATT_WAIT_BAR(N) asm volatile("s_waitcnt vmcnt(" #N ") lgkmcnt(0)\n\ts_barrier" ::: "memory")
#define ATT_WAIT_BAR_N(n) do { if ((n) >= 3) ATT_WAIT_BAR(3); else if ((n) == 2) ATT_WAIT_BAR(2); else if ((n) == 1) ATT_WAIT_BAR(1); else ATT_WAIT_BAR(0); } while (0)
DEVI void kload8(bf16x8 (&kf)[8], const lchar* kp) {
#pragma unroll
    for (int d0 = 0; d0 < 4; ++d0) { kf[2 * d0] = *(const ALAS bf16x8*)(kp + d0 * 2048); kf[2 * d0 + 1] = *(const ALAS bf16x8*)(kp + d0 * 2048 + 512); }
}
template <bool EMASK>
DEVI void qk_softmax(const bf16x8 (&kf)[8], const bf16x8 (&qr)[4], f32x16 (&o)[2], float& m, float& l, const bool first,
                     const float cbase, const float kslope, const int lim_lo, const int lim_hi, ALAS float* wsf, const int lane, u32x4 (&pw)[4]) {
    const int r32 = lane & 31, hi = lane >> 5;
    const float cb = first ? cbase : cbase - m;
    f32x16 p0, p1;
#pragma unroll
    for (int r = 0; r < 16; ++r) { const float lit = (float)((r & 3) + 8 * (r >> 2)); p0[r] = __builtin_fmaf(kslope, lit, cb); p1[r] = __builtin_fmaf(kslope, lit + 32.f, cb); }
    __builtin_amdgcn_s_setprio(1);
#pragma unroll
    for (int d0 = 0; d0 < 4; ++d0) { p0 = ATT_MFMA(kf[2 * d0], qr[d0], p0); p1 = ATT_MFMA(kf[2 * d0 + 1], qr[d0], p1); }
    __builtin_amdgcn_s_setprio(0);
    if (EMASK) {
        const int lo_ = lim_lo - 4 * hi, hi_ = lim_hi - 4 * hi;
#pragma unroll
        for (int r = 0; r < 16; ++r) { const int lit = (r & 3) + 8 * (r >> 2);
            p0[r] = (lit >= lo_ && lit <= hi_) ? p0[r] : NEG; p1[r] = (lit + 32 >= lo_ && lit + 32 <= hi_) ? p1[r] : NEG; }
    }
    float rm, rm2;
    { rm = max3f(p0[0], p0[1], p1[0]); rm2 = max3f(p0[2], p0[3], p1[1]); rm = max3f(rm, p1[2], p1[3]);
#pragma unroll
      for (int r = 4; r < 16; r += 4) { rm = max3f(rm, p0[r], p0[r + 1]); rm2 = max3f(rm2, p0[r + 2], p0[r + 3]); rm = max3f(rm, p1[r], p1[r + 1]); rm2 = max3f(rm2, p1[r + 2], p1[r + 3]); }
      rm = max2f(rm, rm2); }
    { auto rr = __builtin_amdgcn_permlane32_swap(__float_as_uint(rm), __float_as_uint(rm), false, false); rm = max2f(__uint_as_float(rr[0]), __uint_as_float(rr[1])); }
    float dl = 0.f; bool sub;
    if (first) { m = max2f(rm, MFLOOR); dl = m; sub = true; }
    else {
        sub = __any(rm > THR);
        if (sub) {
            dl = max2f(rm, 0.f); m += dl;
            const float alpha = __builtin_amdgcn_exp2f(-dl); l *= alpha;
            wsf[r32] = alpha; ATT_LSYNC();
#pragma unroll
            for (int r = 0; r < 16; ++r) { const float a = wsf[crow(r, hi)]; o[0][r] *= a; o[1][r] *= a; }
            ATT_LSYNC();
        }
    }
    if (sub) {
#pragma unroll
        for (int r = 0; r < 16; ++r) { p0[r] -= dl; p1[r] -= dl; }
    }
    float s = 0.f;
#pragma unroll
    for (int r = 0; r < 16; ++r) { p0[r] = __builtin_amdgcn_exp2f(p0[r]); p1[r] = __builtin_amdgcn_exp2f(p1[r]); s += p0[r] + p1[r]; }
    l += s;
    pw[0] = (u32x4){cvtpk(p0[0], p0[1]), cvtpk(p0[2], p0[3]), cvtpk(p0[4], p0[5]), cvtpk(p0[6], p0[7])};
    pw[1] = (u32x4){cvtpk(p0[8], p0[9]), cvtpk(p0[10], p0[11]), cvtpk(p0[12], p0[13]), cvtpk(p0[14], p0[15])};
    pw[2] = (u32x4){cvtpk(p1[0], p1[1]), cvtpk(p1[2], p1[3]), cvtpk(p1[4], p1[5]), cvtpk(p1[6], p1[7])};
    pw[3] = (u32x4){cvtpk(p1[8], p1[9]), cvtpk(p1[10], p1[11]), cvtpk(p1[12], p1[13]), cvtpk(p1[14], p1[15])};
}
DEVI void pv2(const u32x4 (&pw)[4], const lchar* Vb, f32x16 (&o)[2], const int lane) {
    const int hi = lane >> 5;
    const int va = ((lane >> 4) & 1) * 32 + (lane & 3) * 8 + (4 * hi + ((lane & 15) >> 2)) * 64;
    bf16x8 vf[2][4];
#pragma unroll
    for (int d = 0; d < 2; ++d) { const lchar* vb = Vb + d * 4096 + va;
#pragma unroll
        for (int ks = 0; ks < 4; ++ks) { const s16x4 lo4 = vtr(vb + ks * 1024), hi4 = vtr(vb + ks * 1024 + 512);
            vf[d][ks] = (bf16x8){lo4[0], lo4[1], lo4[2], lo4[3], hi4[0], hi4[1], hi4[2], hi4[3]}; } }
    __builtin_amdgcn_s_setprio(1);
#pragma unroll
    for (int d = 0; d < 2; ++d)
#pragma unroll
        for (int ks = 0; ks < 4; ++ks) o[d] = ATT_MFMA(__builtin_bit_cast(bf16x8, pw[ks]), vf[d][ks], o[d]);
    __builtin_amdgcn_s_setprio(0);
}


#define SBAR() __builtin_amdgcn_sched_barrier(0)
#define PIN(x) asm volatile("" : "+v"(x))
#define fmak(a, K, c) ([&]() { float r_; asm("v_fmamk_f32 %0, %1, %3, %2" : "=v"(r_) : "v"(a), "v"(c), "n"(__builtin_bit_cast(unsigned, (float)(K)))); return r_; }())
DEVI unsigned cvtpk_a(float lo, float hi) { unsigned r; asm("v_cvt_pk_bf16_f32 %0, %1, %2" : "=v"(r) : "v"(lo), "v"(hi)); return r; }
DEVI void kload2(bf16x8 (&kf)[8], const lchar* kp, int d0) { kf[2 * d0] = *(const ALAS bf16x8*)(kp + d0 * 2048); kf[2 * d0 + 1] = *(const ALAS bf16x8*)(kp + d0 * 2048 + 512); }
DEVI float rowmax32(const f32x16& p0, const f32x16& p1) {
    float rm, rm2;
    asm("v_max3_f32 %0, %1, %2, %3\n\tv_max3_f32 %0, %0, %4, %5\n\tv_max3_f32 %0, %0, %6, %7\n\tv_max3_f32 %0, %0, %8, %9\n\tv_max3_f32 %0, %0, %10, %11\n\tv_max3_f32 %0, %0, %12, %13\n\tv_max3_f32 %0, %0, %14, %15\n\tv_max3_f32 %0, %0, %16, %17"
        : "=&v"(rm) : "v"(p0[0]), "v"(p0[1]), "v"(p1[0]), "v"(p1[2]), "v"(p1[3]), "v"(p0[4]), "v"(p0[5]), "v"(p1[4]), "v"(p1[5]), "v"(p0[8]), "v"(p0[9]), "v"(p1[8]), "v"(p1[9]), "v"(p0[12]), "v"(p0[13]), "v"(p1[12]), "v"(p1[13]));
    asm("v_max3_f32 %0, %1, %2, %3\n\tv_max3_f32 %0, %0, %4, %5\n\tv_max3_f32 %0, %0, %6, %7\n\tv_max3_f32 %0, %0, %8, %9\n\tv_max3_f32 %0, %0, %10, %11\n\tv_max3_f32 %0, %0, %12, %13\n\tv_max3_f32 %0, %0, %14, %15"
        : "=&v"(rm2) : "v"(p0[2]), "v"(p0[3]), "v"(p1[1]), "v"(p0[6]), "v"(p0[7]), "v"(p1[6]), "v"(p1[7]), "v"(p0[10]), "v"(p0[11]), "v"(p1[10]), "v"(p1[11]), "v"(p0[14]), "v"(p0[15]), "v"(p1[14]), "v"(p1[15]));
    rm = max2f(rm, rm2);
    auto rr = __builtin_amdgcn_permlane32_swap(__float_as_uint(rm), __float_as_uint(rm), false, false); return max2f(__uint_as_float(rr[0]), __uint_as_float(rr[1])); }
DEVI void emask_apply(f32x16& p0, f32x16& p1, const int lim_lo, const int lim_hi, const int hi) {
    const int lo_ = lim_lo - 4 * hi, hi_ = lim_hi - 4 * hi;
#pragma unroll
    for (int r = 0; r < 16; ++r) { const int lit = (r & 3) + 8 * (r >> 2);
        p0[r] = (lit >= lo_ && lit <= hi_) ? p0[r] : NEG; p1[r] = (lit + 32 >= lo_ && lit + 32 <= hi_) ? p1[r] : NEG; } }
template <class Seq>
DEVI void pipe_pass(lchar* L, const Seq& seq, const bf16_t* Kb, const bf16_t* Vb, const bf16x8 (&qr)[4], f32x16 (&o)[2], float& m_out, float& l_out,
                    const float slope2, const int tpos, ALAS float* wsf, const int wid, const int lane) {
    const int r32 = lane & 31, hi = lane >> 5, NT = seq.NT;
    const unsigned kdst = (unsigned)(uintptr_t)(L + L_K) + (unsigned)wid * 1024u, vdst = (unsigned)(uintptr_t)(L + L_V) + (unsigned)wid * 1024u;
    const unsigned koff = (unsigned)(lane * 64 + wid * 8) * 2u, voff = (unsigned)((16 * (wid & 3) + (lane >> 2)) * 64 + (wid >> 2) * 32 + (lane & 3) * 8) * 2u;
#define PP_DMA_K(d, slot) glds16s(Kb + (size_t)__builtin_amdgcn_readfirstlane(seq.krow(d)) * 64, koff, (unsigned)__builtin_amdgcn_readfirstlane((int)(kdst + (unsigned)(slot))))
#define PP_DMA_V(d, slot) glds16s(Vb + (size_t)__builtin_amdgcn_readfirstlane(seq.krow(d)) * 64, voff, (unsigned)__builtin_amdgcn_readfirstlane((int)(vdst + (unsigned)(slot))))
    const lchar* vp0 = L + L_V + ((lane >> 4) & 1) * 32 + (lane & 3) * 8 + (4 * hi + ((lane & 15) >> 2)) * 64;
    const lchar* kp0 = L + L_K + hi * 1024 + r32 * 16;
    const float posf = (float)(-tpos);
    const unsigned kb16_ = (unsigned)f2bf((float)r32), kb16b_ = (unsigned)f2bf((float)(r32 + 32));
    const unsigned ka0 = hi ? 0u : kb16_ * 0x10001u, ka1 = hi ? 0u : kb16b_ * 0x10001u, kc1 = hi ? 0u : 0x3F803F80u, kc2 = hi ? 0u : 0x00003F80u;
    unsigned qw0, qw1 = 0u, qw2 = 0u;
    { const unsigned h_ = (unsigned)f2bf(slope2); const float rem_ = slope2 - bf2f((bf16_t)h_); qw0 = h_ | ((unsigned)f2bf(rem_) << 16); }
#define PP_CB(d) (seq.vis(d) ? slope2 * ((float)seq.krow(d) + posf) : NEG)
#define PP_QB(cb_) do { const float c0_ = (cb_); const unsigned h1_ = __float_as_uint(c0_) & 0xffff0000u; const float r1_ = c0_ - __uint_as_float(h1_); \
        const unsigned h2_ = __float_as_uint(r1_) & 0xffff0000u; const float r2_ = r1_ - __uint_as_float(h2_); qw1 = __builtin_amdgcn_perm(h2_, h1_, 0x07060302u); qw2 = __float_as_uint(r2_) >> 16; } while (0)
#define PP_BIAS(C0, C1) do { u32x4 ka_ = {ka0, kc1, kc2, 0u}, kb_ = {ka1, kc1, kc2, 0u}; const u32x4 qb_ = {qw0, qw1, qw2, 0u}; \
        C0 = ATT_MFMA(__builtin_bit_cast(bf16x8, ka_), __builtin_bit_cast(bf16x8, qb_), C0); C1 = ATT_MFMA(__builtin_bit_cast(bf16x8, kb_), __builtin_bit_cast(bf16x8, qb_), C1); } while (0)
#define PP_BIAS0(C0, C1) do { u32x4 ka_ = {ka0, kc1, kc2, 0u}, kb_ = {ka1, kc1, kc2, 0u}; const u32x4 qb_ = {qw0, qw1, qw2, 0u}; \
        C0 = ATT_MFMA(__builtin_bit_cast(bf16x8, ka_), __builtin_bit_cast(bf16x8, qb_), Z16); C1 = ATT_MFMA(__builtin_bit_cast(bf16x8, kb_), __builtin_bit_cast(bf16x8, qb_), Z16); } while (0)
    const f32x16 Z16 = {0.f, 0.f, 0.f, 0.f, 0.f, 0.f, 0.f, 0.f, 0.f, 0.f, 0.f, 0.f, 0.f, 0.f, 0.f, 0.f};
#define PP_LIT(r) ((float)(((r) & 3) + 8 * ((r) >> 2)))
    float mhat = 0.f, l_reg = 0.f; bool resc = false;
    f32x16 pA0, pA1, pB0, pB1; bf16x8 kf[8]; s16x4 vlo[8], vhi[8]; u32x4 pw0, pw1, pw2, pw3;
    int sl_prev = 0, sl_cur = 0, sl_next = 8192;
#define PP_ROT() do { sl_prev = sl_cur; sl_cur = sl_next; sl_next = (sl_next == 16384) ? 0 : sl_next + 8192; } while (0)
    int d_0 = seq.desc(0), d_1 = seq.desc(1), d_2 = seq.desc(2), d_3 = seq.desc(3);
    asm volatile("s_waitcnt vmcnt(0)" ::: "memory");
    PP_DMA_K(d_0, 0); PP_DMA_V(d_0, 0); if (NT > 1) PP_DMA_K(d_1, 8192); if (NT > 2) PP_DMA_K(d_2, 16384);
    PP_QB(PP_CB(d_0));
    ATT_WAIT_BAR_N(1 + (NT > 1 ? 1 : 0) + (NT > 2 ? 1 : 0));
#pragma unroll
    for (int d0 = 0; d0 < 4; ++d0) kload2(kf, kp0, d0);
#pragma unroll
    for (int d0 = 0; d0 < 4; ++d0) { pA0 = ATT_MFMA(kf[2 * d0], qr[d0], d0 ? pA0 : Z16); pA1 = ATT_MFMA(kf[2 * d0 + 1], qr[d0], d0 ? pA1 : Z16); }
    PP_BIAS(pA0, pA1);
    if (seq.emask(d_0)) emask_apply(pA0, pA1, seq.lo(d_0), seq.hi_(d_0), hi);
    { mhat = max2f(rowmax32(pA0, pA1), MFLOOR);
#pragma unroll
      for (int r = 0; r < 16; ++r) { pA0[r] = __builtin_amdgcn_exp2f(pA0[r] - mhat); pA1[r] = __builtin_amdgcn_exp2f(pA1[r] - mhat); } }
    ATT_WAIT_BAR(0);
    if (NT > 3) PP_DMA_K(d_3, 0);
    if (NT > 1) { PP_DMA_V(d_1, 8192); PP_ROT();
#pragma unroll
        for (int d0 = 0; d0 < 4; ++d0) kload2(kf, kp0 + sl_cur, d0);
        PP_QB(PP_CB(d_1) - mhat); }
    ATT_WAIT_BAR_N((NT > 3 ? 1 : 0) + (NT > 1 ? 1 : 0));
    d_0 = d_1; d_1 = d_2; d_2 = d_3; d_3 = seq.desc(4);
#define PP_PKW(P, i) cvtpk(P[i], P[i + 1])
#define PP_PAF(k) __builtin_bit_cast(bf16x8, pw##k)
#define PP_VFR(i) (bf16x8){vlo[i][0], vlo[i][1], vlo[i][2], vlo[i][3], vhi[i][0], vhi[i][1], vhi[i][2], vhi[i][3]}
#define PP_VRD(i) do { vlo[i] = vtr(vp_ + (((i) >> 2) * 4096 + ((i) & 3) * 1024)); vhi[i] = vtr(vp_ + (((i) >> 2) * 4096 + ((i) & 3) * 1024 + 512)); } while (0)
#define PP_KRD(d0) do { kload2(kf, kp0 + sl_next, d0); SBAR(); } while (0)
#define PP_GAPA(MF, a0, a1, a2, a3, W0, W1, PW) do { MF; sacc += a0; sacc += a1; sacc += a2; sacc += a3; W0; W1; PIN(PW); PIN(sacc); SBAR(); } while (0)
#define PP_GAPA2(MF, a0, a1, W0, W1, PW) do { MF; sacc += a0; sacc += a1; W0; W1; PIN(PW); PIN(sacc); SBAR(); } while (0)
#define PP_GAPB(MF, X, Y, i, off) do { MF; X[i] = __builtin_amdgcn_exp2f(X[i]); X[i + 1] = __builtin_amdgcn_exp2f(X[i + 1]); X[i + 2] = __builtin_amdgcn_exp2f(X[i + 2]); X[i + 3] = __builtin_amdgcn_exp2f(X[i + 3]); PIN(X); SBAR(); } while (0)
#define PP_STEP(C0, C1, P0, P1, t) do { SBAR(); \
    PP_BIAS0(C0, C1); float cb1_ = PP_CB(d_1); PIN(cb1_); SBAR();                                \
    const lchar* vp_ = vp0 + sl_prev; \
    PP_VRD(0); SBAR(); float sacc = P0[0] + P0[1]; \
                       PP_GAPA(C0 = ATT_MFMA(kf[0], qr[0], C0), P0[2], P0[3], P0[4], P0[5],     pw0[0] = PP_PKW(P0, 0),  pw0[1] = PP_PKW(P0, 2),  pw0); \
    PP_VRD(4); SBAR(); PP_GAPA(C1 = ATT_MFMA(kf[1], qr[0], C1), P0[6], P0[7], P0[8], P0[9],     pw0[2] = PP_PKW(P0, 4),  pw0[3] = PP_PKW(P0, 6),  pw0); \
    PP_VRD(1); SBAR(); PP_GAPA(C0 = ATT_MFMA(kf[2], qr[1], C0), P0[10], P0[11], P0[12], P0[13], pw1[0] = PP_PKW(P0, 8),  pw1[1] = PP_PKW(P0, 10), pw1); \
    PP_VRD(5); SBAR(); PP_GAPA(C1 = ATT_MFMA(kf[3], qr[1], C1), P0[14], P0[15], P1[0], P1[1],   pw1[2] = PP_PKW(P0, 12), pw1[3] = PP_PKW(P0, 14), pw1); \
    PP_VRD(2); SBAR(); PP_GAPA(C0 = ATT_MFMA(kf[4], qr[2], C0), P1[2], P1[3], P1[4], P1[5],     pw2[0] = PP_PKW(P1, 0),  pw2[1] = PP_PKW(P1, 2),  pw2); \
    PP_VRD(6); SBAR(); PP_GAPA(C1 = ATT_MFMA(kf[5], qr[2], C1), P1[6], P1[7], P1[8], P1[9],     pw2[2] = PP_PKW(P1, 4),  pw2[3] = PP_PKW(P1, 6),  pw2); \
    PP_VRD(3); SBAR(); PP_GAPA(C0 = ATT_MFMA(kf[6], qr[3], C0), P1[10], P1[11], P1[12], P1[13], pw3[0] = PP_PKW(P1, 8),  pw3[1] = PP_PKW(P1, 10), pw3); \
    PP_VRD(7); SBAR(); PP_GAPA2(C1 = ATT_MFMA(kf[7], qr[3], C1), P1[14], P1[15],                pw3[2] = PP_PKW(P1, 12), pw3[3] = PP_PKW(P1, 14), pw3); \
    l_reg += sacc; \
    const bool ik_ = (t) + 3 < NT, iv_ = (t) + 1 < NT; \
    if (ik_) PP_DMA_K(d_3, sl_cur); if (iv_) PP_DMA_V(d_1, sl_next);                                     \
    if (seq.emask(d_0)) emask_apply(C0, C1, seq.lo(d_0), seq.hi_(d_0), hi); \
    { const float rm = rowmax32(C0, C1); resc = false;                                                   \
      if (__builtin_expect(__any(rm > THR), 0)) { const float dl = max2f(rm, 0.f); mhat += dl;           \
          const float f = __builtin_amdgcn_exp2f(-dl); l_reg *= f; if (hi == 0) wsf[r32] = f; resc = true; \
          _Pragma("unroll") for (int r = 0; r < 16; ++r) { C0[r] -= dl; C1[r] -= dl; } } } \
    PP_QB(cb1_ - mhat); const int d_4 = seq.desc((t) + 4); SBAR(); \
    PP_GAPB(o[0] = ATT_MFMA(PP_PAF(0), PP_VFR(0), o[0]), C0, P0, 0, 0.f);               PP_GAPB(o[1] = ATT_MFMA(PP_PAF(0), PP_VFR(4), o[1]), C0, P0, 4, 0.f); \
    PP_KRD(0); PP_GAPB(o[0] = ATT_MFMA(PP_PAF(1), PP_VFR(1), o[0]), C0, P0, 8, 0.f);    PP_KRD(1); PP_GAPB(o[1] = ATT_MFMA(PP_PAF(1), PP_VFR(5), o[1]), C0, P0, 12, 0.f); \
    PP_KRD(2); PP_GAPB(o[0] = ATT_MFMA(PP_PAF(2), PP_VFR(2), o[0]), C1, P1, 0, 32.f);   PP_KRD(3); PP_GAPB(o[1] = ATT_MFMA(PP_PAF(2), PP_VFR(6), o[1]), C1, P1, 4, 32.f); \
    PP_GAPB(o[0] = ATT_MFMA(PP_PAF(3), PP_VFR(3), o[0]), C1, P1, 8, 32.f);              PP_GAPB(o[1] = ATT_MFMA(PP_PAF(3), PP_VFR(7), o[1]), C1, P1, 12, 32.f); \
    ATT_WAIT_BAR_N((ik_ ? 1 : 0) + (iv_ ? 1 : 0));                                                        \
    if (resc) { _Pragma("unroll") for (int d_ = 0; d_ < 2; ++d_) _Pragma("unroll") for (int r = 0; r < 16; ++r) o[d_][r] *= wsf[crow(r, hi)]; } \
    PP_ROT(); d_0 = d_1; d_1 = d_2; d_2 = d_3; d_3 = d_4; \
    } while (0)
#define PP_DRAIN(P0, P1) do { float sacc = P0[0] + P0[1]; \
      _Pragma("unroll") for (int r = 2; r < 16; ++r) sacc += P0[r]; \
      _Pragma("unroll") for (int r = 0; r < 16; ++r) sacc += P1[r]; \
      l_reg += sacc; \
      pw0 = (u32x4){PP_PKW(P0, 0), PP_PKW(P0, 2), PP_PKW(P0, 4), PP_PKW(P0, 6)}; pw1 = (u32x4){PP_PKW(P0, 8), PP_PKW(P0, 10), PP_PKW(P0, 12), PP_PKW(P0, 14)}; \
      pw2 = (u32x4){PP_PKW(P1, 0), PP_PKW(P1, 2), PP_PKW(P1, 4), PP_PKW(P1, 6)}; pw3 = (u32x4){PP_PKW(P1, 8), PP_PKW(P1, 10), PP_PKW(P1, 12), PP_PKW(P1, 14)}; \
      const lchar* vp_ = vp0 + sl_prev; _Pragma("unroll") for (int i = 0; i < 8; ++i) PP_VRD(i); \
      o[0] = ATT_MFMA(PP_PAF(0), PP_VFR(0), o[0]); o[1] = ATT_MFMA(PP_PAF(0), PP_VFR(4), o[1]); o[0] = ATT_MFMA(PP_PAF(1), PP_VFR(1), o[0]); o[1] = ATT_MFMA(PP_PAF(1), PP_VFR(5), o[1]); \
      o[0] = ATT_MFMA(PP_PAF(2), PP_VFR(2), o[0]); o[1] = ATT_MFMA(PP_PAF(2), PP_VFR(6), o[1]); o[0] = ATT_MFMA(PP_PAF(3), PP_VFR(3), o[0]); o[1] = ATT_MFMA(PP_PAF(3), PP_VFR(7), o[1]); } while (0)
    int t = 1;
#pragma unroll 1
    for (; t + 1 < NT; t += 2) {
        PP_STEP(pB0, pB1, pA0, pA1, t);
        PP_STEP(pA0, pA1, pB0, pB1, t + 1);
    }
    if (t < NT) { PP_STEP(pB0, pB1, pA0, pA1, t); SBAR(); PP_DRAIN(pB0, pB1); }
    else { SBAR(); PP_DRAIN(pA0, pA1); }
    m_out = mhat; l_out = l_reg;
    ATT_BAR();
#undef PP_DMA_K
#undef PP_DMA_V
#undef PP_CB
#undef PP_QB
#undef PP_BIAS
#undef PP_BIAS0
#undef PP_ROT
#undef PP_STEP
#undef PP_DRAIN
}
struct NsaSeq {
    int vlist, NT; unsigned long long rmask; int c, tokloc, wblk;
    DEVI int desc(int i) const { return __builtin_amdgcn_readlane(vlist, i & 63); }
    DEVI int krow(int d) const { return 64 * (d & 63); }
    DEVI bool vis(int d) const { return !(d & 64) && ((rmask >> (d & 63)) & 1ull); }
    DEVI bool emask(int d) const { return d == c || d == wblk; }
    DEVI int lo(int d) const { return d == wblk ? tokloc + 1 : -BIG; }
    DEVI int hi_(int d) const { return d == c ? tokloc : BIG; }
};
struct MobaSeq {
    int cur, NT, widh, tq; unsigned sel;
    DEVI int desc(int i) const { return i; }
    DEVI int krow(int i) const { return (cur + 1) * 256 - 64 * (i + 1); }
    DEVI bool own(int i) const { return i < 4; }
    DEVI bool vis(int i) const { return own(i) ? ((3 - i) <= widh) : (((sel >> ((cur - (i >> 2)) & 31)) & 1u) != 0u); }
    DEVI bool emask(int i) const { return own(i) && (3 - i) == widh; }
    DEVI int lo(int) const { return -BIG; }
    DEVI int hi_(int i) const { return tq - 64 * (3 - i); }
};

template <class RowF>
DEVI void store_y(const ALAS float* ot, const bf16_t* Zb, bf16_t* Y, const RowF& rf, int lane) {
    u32x4 z[4];
#pragma unroll
    for (int i = 0; i < 4; ++i) { const int ci = i * 64 + lane, q = ci >> 3, ch = ci & 7; z[i] = *(const u32x4*)(Zb + rf.zoff(q) + ch * 8); }
#pragma unroll
    for (int i = 0; i < 4; ++i) {
        const int ci = i * 64 + lane, q = ci >> 3, ch = ci & 7;
        const f32x4 v0 = *(const ALAS f32x4*)(ot + q * 64 + ch * 8), v1 = *(const ALAS f32x4*)(ot + q * 64 + ch * 8 + 4);
        u32x4 w;
        w.x = cvtpk(v0[0] * __uint_as_float(z[i].x << 16), v0[1] * __uint_as_float(z[i].x & 0xffff0000u)); w.y = cvtpk(v0[2] * __uint_as_float(z[i].y << 16), v0[3] * __uint_as_float(z[i].y & 0xffff0000u));
        w.z = cvtpk(v1[0] * __uint_as_float(z[i].z << 16), v1[1] * __uint_as_float(z[i].z & 0xffff0000u)); w.w = cvtpk(v1[2] * __uint_as_float(z[i].w << 16), v1[3] * __uint_as_float(z[i].w & 0xffff0000u));
        *(u32x4*)(Y + rf.yoff(q) + ch * 8) = w;
    }
    ATT_LSYNC();
}

struct NsaRows { size_t hs; int rowb, g; DEVI size_t zoff(int q) const { return (size_t)(g * 4 + (q & 3)) * hs + (size_t)(rowb + (q >> 2)) * 64; } DEVI size_t yoff(int q) const { return (size_t)(rowb + (q >> 2)) * 1024 + (g * 4 + (q & 3)) * 64; } };
struct MobaRows { size_t hs; int rowb, h; DEVI size_t zoff(int q) const { return (size_t)(8 + h) * hs + (size_t)(rowb + q) * 64; } DEVI size_t yoff(int q) const { return (size_t)(rowb + q) * 1024 + 512 + h * 64; } };

DEVI void nsa_unit(const Params& P, lchar* L, const int b, const int g, const int c, const int wid) {
    const int lane = lane_id_opaque(), r32 = lane & 31, hi = lane >> 5;
    const bf16_t* ATT = (const bf16_t*)(P.ws + WS_ATT); const size_t HS = (size_t)MROWS * 64;
    lchar* Wv = L + L_WAVE + wid * WAVE_BYTES;
    ALAS float* wsf = (ALAS float*)(Wv + W_WSF); ALAS float* IMP = (ALAS float*)(Wv + W_IMP);
    ALAS unsigned long long* MASKS = (ALAS unsigned long long*)(Wv + W_MASK); ALAS float* OT = (ALAS float*)(Wv + W_OT);
    ALAS unsigned long long* WUN = (ALAS unsigned long long*)(L + L_WG);
    const int tokloc = wid * 8 + (r32 >> 2), hh = g * 4 + (r32 & 3);
    const int t = c * 64 + tokloc, row = b * SEQ + t;
    const float slope2 = exp2f(-(float)(2 * hh + 1) * 0.5f) * LOG2E;
    bf16x8 qr[4];
    { const bf16_t* qp = ATT + (size_t)(HC_QA + hh) * HS + (size_t)row * 64 + hi * 8;
#pragma unroll
      for (int d0 = 0; d0 < 4; ++d0) qr[d0] = *(const bf16x8*)(qp + d0 * 16); }
    const float* Gp = (const float*)(P.ws + WS_G) + (size_t)row * 24 + hh;
    unsigned long long U, wun = 0ull, mymask;
    Stage st;
    {
        const bf16_t* KCb = (const bf16_t*)(P.ws + WS_KC) + (size_t)(b * 2 + g) * 256 * 64; const bf16_t* VCb = (const bf16_t*)(P.ws + WS_VC) + (size_t)(b * 2 + g) * 256 * 64;
        const int nblk = ((4 * c + 2) >> 6) + 1, nlim = (t - 31) >> 4;
        f32x16 o[4];
#pragma unroll
        for (int d = 0; d < 4; ++d)
#pragma unroll
            for (int r = 0; r < 16; ++r) o[d][r] = 0.f;
        float m = 0.f, l = 0.f; bool first = true;
#define OV_TILE(bb, dstoff) do { const int p_ = wid * 64 + lane, dh_ = p_ >> 8, kk_ = (p_ >> 2) & 63, c4_ = p_ & 3, n_ = 64 * (bb) + kk_; \
            const int jr_ = (n_ >> 2) - (dh_ * 32 + c4_ * 8);                           \
            unsigned m8_ = ((unsigned)jr_ < 8u ? 1u << jr_ : 0u) | (((n_ & 3) == 3 && (unsigned)(jr_ + 1) < 8u) ? 1u << (jr_ + 1) : 0u); if (n_ >= 255) m8_ = 0u; \
            unsigned w_[4]; _Pragma("unroll") for (int e_ = 0; e_ < 4; ++e_) w_[e_] = ((m8_ >> (2 * e_)) & 1u) * 0x3F80u | ((m8_ >> (2 * e_ + 1)) & 1u) * 0x3F800000u; \
            *(ALAS u32x4*)(L + L_OVT + (dstoff) + dh_ * 4096 + kk_ * 64 + c4_ * 16) = (u32x4){w_[0], w_[1], w_[2], w_[3]}; } while (0)
        stage_load(st, KCb, VCb, wid, lane); stage_write(st, L + L_K, L + L_V, wid, lane); OV_TILE(0, 0); ATT_BAR();
        for (int i = 0; i < nblk; ++i) {
            const int buf = i & 1;
            if (i + 1 < nblk) stage_load(st, KCb + (i + 1) * 4096, VCb + (i + 1) * 4096, wid, lane);
            const float cbase = slope2 * (float)(16 * (64 * i + 4 * hi) + 31 - t);
            flash_block<4, true>(L + L_K + buf * 8192, L + L_V + buf * 8192, L + L_OVT + buf * 8192, qr, o, m, l, first, cbase, slope2 * 16.f, -BIG, nlim - 64 * i, wsf, lane);
            first = false;
            __builtin_amdgcn_sched_barrier(0);
            if (i + 1 < nblk) { stage_write(st, L + L_K + (buf ^ 1) * 8192, L + L_V + (buf ^ 1) * 8192, wid, lane); OV_TILE(i + 1, (buf ^ 1) * 8192); }
            ATT_BAR();
        }
        const float lt = swap_sum(l), rl = lt > 0.f ? 1.f / lt : 0.f;
        wsf[r32] = Gp[0] * rl; wsf[64 + r32] = rl; ATT_LSYNC();
#pragma unroll
        for (int d0 = 0; d0 < 2; ++d0)
#pragma unroll
            for (int r = 0; r < 16; ++r) OT[crow(r, hi) * 64 + d0 * 32 + r32] = o[d0][r] * wsf[crow(r, hi)];
#pragma unroll
        for (int d0 = 0; d0 < 2; ++d0)
#pragma unroll
            for (int g4 = 0; g4 < 4; ++g4) { float v = 0.f;
#pragma unroll
                for (int p = 0; p < 4; ++p) v += o[2 + d0][4 * g4 + p] * wsf[64 + crow(4 * g4 + p, hi)];
                IMP[(2 * g4 + hi) * 64 + d0 * 32 + r32] = v; }
        ATT_LSYNC();
#pragma unroll 1
        for (int tk = 0; tk < 8; ++tk) {
            float v = IMP[tk * 64 + lane];
            if (lane == 0 || lane == c || lane == c - 1) v = INFINITY;
            if (lane > c) v = -INFINITY;
            const unsigned bits = __float_as_uint(v), key = bits ^ ((bits & 0x80000000u) ? 0xffffffffu : 0x80000000u);
            unsigned T = 0u;
#pragma unroll 1
            for (int bit = 31; bit >= 0; --bit) { const unsigned cand = T | (1u << bit); const int cnt = __builtin_popcountll(__ballot(key >= cand)); if (cnt >= 16) { T = cand; if (cnt == 16) break; } }
            const unsigned long long gt = __ballot(key > T), eq = __ballot(key == T);
            const int need = 16 - __builtin_popcountll(gt);
            const int below = (int)__builtin_amdgcn_mbcnt_hi((unsigned)(eq >> 32), __builtin_amdgcn_mbcnt_lo((unsigned)eq, 0u));
            const bool selj = (key > T) || (key == T && below < need);
            const unsigned long long mk = __ballot(selj && lane <= c);
            if (lane == 0) MASKS[tk] = mk;
            wun |= mk; }
        if (lane == 0) WUN[wid] = wun;
        ATT_BAR();
        U = 0ull;
#pragma unroll
        for (int w = 0; w < 8; ++w) U |= WUN[w];
        U = ((unsigned long long)(unsigned)__builtin_amdgcn_readfirstlane((int)(U >> 32)) << 32) | (unsigned long long)(unsigned)__builtin_amdgcn_readfirstlane((int)(unsigned)U);
    }
    const int laneB = lane_id_opaque(), r32B = laneB & 31, hiB = laneB >> 5, toklocB = wid * 8 + (r32B >> 2), hhB = g * 4 + (r32B & 3), tB = c * 64 + toklocB;
    const float slope2B = exp2f(-(float)(2 * hhB + 1) * 0.5f) * LOG2E;
    const float* GpB = (const float*)(P.ws + WS_G) + (size_t)(b * SEQ + tB) * 24 + hhB;
    mymask = MASKS[r32B >> 2];
#pragma unroll
    for (int pass = 1; pass <= 2; ++pass) {
        const bf16_t* Kb = ATT + (size_t)((pass == 1 ? HC_KS : HC_KW) + g) * HS + (size_t)b * SEQ * 64;
        const bf16_t* Vb = ATT + (size_t)((pass == 1 ? HC_VS : HC_VW) + g) * HS + (size_t)b * SEQ * 64;
        const int jlow = c >= 8 ? c - 8 : 0;
        const unsigned long long upto = (c == 63) ? ~0ull : ((1ull << (c + 1)) - 1ull);
        const unsigned long long Ucur = (pass == 1) ? U : (upto & ~((1ull << jlow) - 1ull));
        const unsigned long long wneed = (pass == 1) ? wun : ~0ull, rmask = (pass == 1) ? mymask : ~0ull;
        f32x16 o[2];
#pragma unroll
        for (int d = 0; d < 2; ++d)
#pragma unroll
            for (int r = 0; r < 16; ++r) o[d][r] = 0.f;
        float m = 0.f, l = 0.f;
        ALAS unsigned char* TL = (ALAS unsigned char*)(L + L_TL);
        const int ntraw = (int)__builtin_popcountll(Ucur);
        if (wid == 0 && laneB == 0) TL[ntraw] = (unsigned char)64;
        if (wid == 0 && ((Ucur >> laneB) & 1ull)) TL[__builtin_popcountll(laneB == 63 ? 0ull : (Ucur >> (laneB + 1)))] = (unsigned char)laneB;
        ATT_BAR();
        const NsaSeq seq{(int)TL[laneB], ntraw, rmask, c, toklocB, (pass == 2 && c >= 8) ? c - 8 : -1};
        pipe_pass(L, seq, Kb, Vb, qr, o, m, l, slope2B, tB, wsf, wid, laneB);
        const float lt = swap_sum(l), rl = lt > 0.f ? 1.f / lt : 0.f;
        wsf[r32B] = GpB[8 * pass] * rl; ATT_LSYNC();
#pragma unroll
        for (int d0 = 0; d0 < 2; ++d0)
#pragma unroll
            for (int r = 0; r < 16; ++r) OT[crow(r, hiB) * 64 + d0 * 32 + r32B] += o[d0][r] * wsf[crow(r, hiB)];
        ATT_LSYNC();
    }
    const NsaRows rf{HS, b * SEQ + c * 64 + wid * 8, g};
    store_y(OT, (const bf16_t*)(P.ws + WS_Z), (bf16_t*)(P.ws + WS_Y), rf, laneB);
}

DEVI void moba_unit(const Params& P, lchar* L, const int b, const int h, const int cur, const int wid) {
    const int lane = lane_id_opaque(), r32 = lane & 31, hi = lane >> 5; const int tid = wid * 64 + lane;
    const bf16_t* ATT = (const bf16_t*)(P.ws + WS_ATT); const size_t HS = (size_t)MROWS * 64;
    lchar* Wv = L + L_WAVE + wid * WAVE_BYTES;
    ALAS float* wsf = (ALAS float*)(Wv + W_WSF); ALAS float* OT = (ALAS float*)(Wv + W_OT);
    const int tq = 32 * wid + r32, t = cur * 256 + tq, row = b * SEQ + t;
    const float slope2 = exp2f(-(float)(h + 1)) * LOG2E;
    bf16x8 qr[4];
    { const bf16_t* qp = ATT + (size_t)(HC_QB + h) * HS + (size_t)row * 64 + hi * 8;
#pragma unroll
      for (int d0 = 0; d0 < 4; ++d0) qr[d0] = *(const bf16x8*)(qp + d0 * 16); }
    unsigned sel = 0u;
    if (cur > 0) {
        const float* kbp = (const float*)(P.ws + WS_KBAR) + (size_t)((b * 8 + h) * 16) * 64;
        lchar* KH = L + L_KBT; lchar* KL = L + L_KBT + 4096;
        for (int e = tid; e < 1024; e += NT) { const int key = e >> 6, d = e & 63; const float v = kbp[e]; const bf16_t vh = f2bf(v), vl = f2bf(v - bf2f(vh));
            const int off = (d >> 3) * 512 + key * 16 + (d & 7) * 2; *(ALAS bf16_t*)(KH + off) = vh; *(ALAS bf16_t*)(KL + off) = vl; }
        ATT_BAR();
        f32x16 ga;
#pragma unroll
        for (int r = 0; r < 16; ++r) ga[r] = 0.f;
        const lchar* kh = KH + hi * 512 + r32 * 16; const lchar* kl = KL + hi * 512 + r32 * 16;
#pragma unroll
        for (int d0 = 0; d0 < 4; ++d0) { ga = ATT_MFMA(*(const ALAS bf16x8*)(kh + d0 * 1024), qr[d0], ga); ga = ATT_MFMA(*(const ALAS bf16x8*)(kl + d0 * 1024), qr[d0], ga); }
        float own[8], oth[8], G[16];
#pragma unroll
        for (int r = 0; r < 8; ++r) { own[r] = ga[r]; oth[r] = swap_other(own[r], hi); }
#pragma unroll
        for (int idx = 0; idx < 16; ++idx) { const int half = (idx >> 2) & 1, rs = (idx & 3) + 4 * (idx >> 3); const float v = (half == hi) ? own[rs] : oth[rs]; G[idx] = (idx < cur) ? v : -INFINITY; }
#pragma unroll
        for (int k = 0; k < 3; ++k) { float best = -INFINITY; int bi = -1;
#pragma unroll
            for (int idx = 0; idx < 16; ++idx) { const bool ok = (G[idx] > best) && !((sel >> idx) & 1u); best = ok ? G[idx] : best; bi = ok ? idx : bi; }
            if (bi >= 0) sel |= 1u << bi; }
    }
    const bf16_t* Kb = ATT + (size_t)(HC_KB + h) * HS + (size_t)b * SEQ * 64; const bf16_t* Vb = ATT + (size_t)(HC_VB + h) * HS + (size_t)b * SEQ * 64;
    f32x16 o[2];
#pragma unroll
    for (int d = 0; d < 2; ++d)
#pragma unroll
        for (int r = 0; r < 16; ++r) o[d][r] = 0.f;
    float m = 0.f, l = 0.f;
    const MobaSeq seq{cur, 4 * (cur + 1), wid >> 1, tq, sel};
    pipe_pass(L, seq, Kb, Vb, qr, o, m, l, slope2, t, wsf, wid, lane);
    const float lt = swap_sum(l), rl = lt > 0.f ? 1.f / lt : 0.f;
    wsf[r32] = rl; ATT_LSYNC();
#pragma unroll
    for (int d0 = 0; d0 < 2; ++d0)
#pragma unroll
        for (int r = 0; r < 16; ++r) OT[crow(r, hi) * 64 + d0 * 32 + r32] = o[d0][r] * wsf[crow(r, hi)];
    ATT_LSYNC();
    const MobaRows rf{HS, b * SEQ + cur * 256 + wid * 32, h};
    store_y(OT, (const bf16_t*)(P.ws + WS_Z), (bf16_t*)(P.ws + WS_Y), rf, lane);
}


DEVI void phase_gates(const Params& P, lchar* L, const int wid) {
    const int lane = lane_id_opaque(), r32 = lane & 31, hi = lane >> 5;
    constexpr int SLOT = 36864, BO = 32768;
    const unsigned lbase = (unsigned)(uintptr_t)L;
    const int ul = lane >> 4, sl = lane & 15;
#pragma unroll 1
    for (int panel = blockIdx.x; panel < MROWS / 256; panel += gridDim.x) {
        const char* Ab = (const char*)((const bf16_t*)(P.ws + WS_U) + (size_t)panel * 256 * DM);
        const char* Bb = (const char*)((const bf16_t*)(P.ws + WS_WIN) + (size_t)5888 * DM);
        unsigned aoff[4], boff;
#pragma unroll
        for (int j = 0; j < 4; ++j) { const int u = 16 * wid + 4 * j + ul, val = sl ^ (u & 15); aoff[j] = (unsigned)((2 * u + (val >> 3)) * 2048 + (val & 7) * 16); }
        { const int u = 4 * (wid & 3) + ul, val = sl ^ (u & 15); boff = (unsigned)((2 * u + (val >> 3)) * 2048 + (val & 7) * 16); }
#define GT_ISSUE(c_) do { const unsigned d_ = lbase + (unsigned)(((c_) & 3) * SLOT); \
            _Pragma("unroll") for (int j = 0; j < 4; ++j) glds16s(Ab + (size_t)(c_) * 128, aoff[j], (unsigned)__builtin_amdgcn_readfirstlane((int)(d_ + (unsigned)wid * 4096u + (unsigned)j * 1024u))); \
            glds16s(Bb + (size_t)(c_) * 128, boff, (unsigned)__builtin_amdgcn_readfirstlane((int)(d_ + (unsigned)BO + (unsigned)(wid & 3) * 1024u))); } while (0)
        int aad[4], bad[4];
        { const int ra = 32 * wid + r32, ua = ra >> 1, ca = (((ra & 1) << 3) | hi) ^ (ua & 15); const int ub = r32 >> 1, cb = (((r32 & 1) << 3) | hi) ^ (ub & 15);
#pragma unroll
          for (int ks = 0; ks < 4; ++ks) { aad[ks] = ua * 256 + ((ca ^ (2 * ks)) * 16); bad[ks] = BO + ub * 256 + ((cb ^ (2 * ks)) * 16); } }
        f32x16 acc;
#pragma unroll
        for (int r = 0; r < 16; ++r) acc[r] = 0.f;
        asm volatile("s_waitcnt vmcnt(0)" ::: "memory");
        GT_ISSUE(0); GT_ISSUE(1); GT_ISSUE(2);
#pragma unroll 1
        for (int c = 0; c < 16; ++c) {
            if (c + 2 < 16) asm volatile("s_waitcnt vmcnt(10) lgkmcnt(0)\n\ts_barrier" ::: "memory");
            else if (c + 1 < 16) asm volatile("s_waitcnt vmcnt(5) lgkmcnt(0)\n\ts_barrier" ::: "memory");
            else asm volatile("s_waitcnt vmcnt(0) lgkmcnt(0)\n\ts_barrier" ::: "memory");
            if (c + 3 < 16) GT_ISSUE(c + 3);
            const lchar* sb = L + (c & 3) * SLOT;
#pragma unroll
            for (int ks = 0; ks < 4; ++ks) { const bf16x8 a = *(const ALAS bf16x8*)(sb + aad[ks]), bb = *(const ALAS bf16x8*)(sb + bad[ks]); acc = ATT_MFMA(bb, a, acc); }
        }
#undef GT_ISSUE
        float* Gd = (float*)(P.ws + WS_G) + (size_t)(panel * 256 + 32 * wid + r32) * 24;
#pragma unroll
        for (int q4 = 0; q4 < 3; ++q4) { f32x4 v;
#pragma unroll
            for (int j = 0; j < 4; ++j) { const float x = acc[4 * q4 + j]; v[j] = __builtin_amdgcn_rcpf(1.f + __builtin_amdgcn_exp2f(-1.4426950408889634f * x)); }
            *(f32x4*)(Gd + 8 * q4 + 4 * hi) = v; }
        ATT_BAR();
    }
}

DEVI void phase_compress(const Params& P, lchar* L, const int wid) {
    const int lane = lane_id_opaque(), r32 = lane & 31, hi = lane >> 5;
    const bf16_t* ATT = (const bf16_t*)(P.ws + WS_ATT); const size_t HS = (size_t)MROWS * 64;
    constexpr int HP = 272;
    const int wm = wid >> 2, wn = wid & 3;
#pragma unroll 1
    for (int item = blockIdx.x; item < 256; item += gridDim.x) {
        const int q = item & 3, inst = item >> 2, g = inst & 1, b = (inst >> 1) & 15, which = inst >> 5;
        const bf16_t* X = ATT + (size_t)((which ? HC_VCMP : HC_KCMP) + g) * HS + (size_t)b * SEQ * 64;
        const bf16_t* W1T = (const bf16_t*)(P.ws + (which ? WS_W1V : WS_W1K)); const bf16_t* W2T = (const bf16_t*)(P.ws + (which ? WS_W2V : WS_W2K));
        const float* B1P = (const float*)(P.ws + WS_B1P) + which * 8 * 128;
        bf16_t* OUT = (bf16_t*)(P.ws + (which ? WS_VC : WS_KC)) + (size_t)((b * 2 + g) * 256 + 64 * q) * 64;
        const int n0 = 64 * q + 32 * wm, e0 = 32 * wn;
        f32x16 acc;
#pragma unroll
        for (int r = 0; r < 16; ++r) acc[r] = 0.f;
        {
            constexpr int SLOT = 24576, XO = 16384, HOFF = 4 * SLOT;
            const unsigned lbase = (unsigned)(uintptr_t)L;
            const int ul = lane >> 4, sl = lane & 15;
            unsigned woff[2], xoff;
#pragma unroll
            for (int j = 0; j < 2; ++j) { const int u = 4 * wid + ul + 32 * j, val = sl ^ (u & 15); woff[j] = (unsigned)((2 * u + (val >> 3)) * 4096 + (val & 7) * 16); }
            { const int u = 4 * wid + ul, val = sl ^ (u & 15); xoff = (unsigned)((2 * u + (val >> 3)) * 2048 + (val & 7) * 16); }
            const char* Wb = (const char*)W1T; const char* Xb = (const char*)(X + (size_t)(64 * q) * 1024);
#define CMP_ISSUE(c_) do { const unsigned d_ = lbase + (unsigned)(((c_) & 3) * SLOT) + (unsigned)wid * 1024u; \
                glds16s(Wb + (size_t)(c_) * 128, woff[0], (unsigned)__builtin_amdgcn_readfirstlane((int)d_)); glds16s(Wb + (size_t)(c_) * 128, woff[1], (unsigned)__builtin_amdgcn_readfirstlane((int)(d_ + 8192u))); \
                glds16s(Xb + (size_t)(c_) * 128, xoff, (unsigned)__builtin_amdgcn_readfirstlane((int)(d_ + (unsigned)XO))); } while (0)
            int aad[4], bad[4];
            { const int ra = e0 + r32, ua = ra >> 1, ca = (((ra & 1) << 3) | hi) ^ (ua & 15); const int rb = 32 * wm + r32, ub = rb >> 1, cb = (((rb & 1) << 3) | hi) ^ (ub & 15);
#pragma unroll
              for (int ks = 0; ks < 4; ++ks) { aad[ks] = ua * 256 + ((ca ^ (2 * ks)) * 16); bad[ks] = XO + ub * 256 + ((cb ^ (2 * ks)) * 16); } }
            asm volatile("s_waitcnt vmcnt(0)" ::: "memory");
            CMP_ISSUE(0); CMP_ISSUE(1); CMP_ISSUE(2);
#pragma unroll 1
            for (int c = 0; c < 32; ++c) {
                if (c + 2 < 32) asm volatile("s_waitcnt vmcnt(6) lgkmcnt(0)\n\ts_barrier" ::: "memory");
                else if (c + 1 < 32) asm volatile("s_waitcnt vmcnt(3) lgkmcnt(0)\n\ts_barrier" ::: "memory");
                else asm volatile("s_waitcnt vmcnt(0) lgkmcnt(0)\n\ts_barrier" ::: "memory");
                if (c + 3 < 32) CMP_ISSUE(c + 3);
                const lchar* sb = L + (c & 3) * SLOT;
#pragma unroll
                for (int ks = 0; ks < 4; ++ks) { const bf16x8 a = *(const ALAS bf16x8*)(sb + aad[ks]), bb = *(const ALAS bf16x8*)(sb + bad[ks]); acc = ATT_MFMA(a, bb, acc); }
            }
#undef CMP_ISSUE
            (void)HOFF;
        }
#pragma unroll
        for (int g4 = 0; g4 < 4; ++g4) { float v[4];
#pragma unroll
            for (int j = 0; j < 4; ++j) { const int e = e0 + 8 * g4 + 4 * hi + j; float bs = 0.f;
#pragma unroll
                for (int c = 0; c < 8; ++c) bs += B1P[c * 128 + e];
                const float x = acc[4 * g4 + j] + bs; v[j] = x * __builtin_amdgcn_rcpf(1.f + __builtin_amdgcn_exp2f(-1.4426950408889634f * x)); }
            u32x2 w; w.x = cvtpk(v[0], v[1]); w.y = cvtpk(v[2], v[3]);
            *(ALAS u32x2*)(L + 98304 + (32 * wm + r32) * HP + (e0 + 8 * g4 + 4 * hi) * 2) = w; }
        ATT_BAR();
        if (wid < 4) {
            const int wm2 = wid >> 1, f0 = 32 * (wid & 1);
            f32x16 a2;
#pragma unroll
            for (int r = 0; r < 16; ++r) a2[r] = 0.f;
            const lchar* hp = L + 98304 + (32 * wm2 + r32) * HP + hi * 16; const bf16_t* wp = W2T + (size_t)(f0 + r32) * 128 + hi * 8;
#pragma unroll
            for (int ks = 0; ks < 8; ++ks) { const bf16x8 a = *(const ALAS bf16x8*)(hp + ks * 32), bb = *(const bf16x8*)(wp + ks * 16); a2 = ATT_MFMA(a, bb, a2); }
#pragma unroll
            for (int r = 0; r < 16; ++r) { const int nl = 32 * wm2 + crow(r, hi); const bool pad = (64 * q + nl == 255);
                OUT[(size_t)nl * 64 + f0 + r32] = pad ? (bf16_t)0 : f2bf(a2[r]); }
        }
        ATT_BAR();
    }
    { const int gw = blockIdx.x * (NT / 64) + wid, ngw = (gridDim.x * NT) >> 6; float* KBAR = (float*)(P.ws + WS_KBAR);
      for (int it = gw; it < NB * 8 * 16; it += ngw) { const int n = it & 15, h = (it >> 4) & 7, b = it >> 7;
          const bf16_t* src = ATT + ((size_t)(HC_KB + h) * MROWS + (size_t)b * SEQ + n * 256) * 64; float s0 = 0.f, s1 = 0.f, s2 = 0.f, s3 = 0.f;
          for (int r = 0; r < 256; r += 4) { s0 += bf2f(src[r * 64 + lane]); s1 += bf2f(src[(r + 1) * 64 + lane]); s2 += bf2f(src[(r + 2) * 64 + lane]); s3 += bf2f(src[(r + 3) * 64 + lane]); }
          KBAR[(size_t)it * 64 + lane] = ((s0 + s1) + (s2 + s3)) * (1.f / 256.f); } }
}

DEVI void phase_attention(const Params& P, lchar* L, const int wid) {
    const int tid = wid * 64 + lane_id_opaque();
    const int G = gridDim.x, k = blockIdx.x;
    const int nU = (G == 256) ? 8 : ((2048 - k + G - 1) / G);
#pragma unroll 1
    for (int rep_ = 0; rep_ < 1 + PROBE_NSA2; ++rep_)
#pragma unroll 1
    for (int i = 0; i < (NAIVE_NSA ? 0 : nU); ++i) { int bg, c;
        if (G == 256) { bg = k & 31; const int base = k >> 5; c = 8 * i + ((i & 1) ? 7 - base : base); } else { const int u = k + i * G; bg = u & 31; c = u >> 5; }
        nsa_unit(P, L, bg >> 1, bg & 1, c, wid); }
#pragma unroll 1
    for (int rep_ = 0; rep_ < 1 + PROBE_MOBA2; ++rep_)
#pragma unroll 1
    for (int i = 0; i < (NAIVE_MOBA ? 0 : nU); ++i) { int bh, cur;
        if (G == 256) { bh = k & 127; const int base = k >> 7; cur = 2 * i + ((i & 1) ? 1 - base : base); } else { const int u = k + i * G; bh = u & 127; cur = u >> 7; }
        moba_unit(P, L, bh >> 3, bh & 7, cur, wid); }
}
}

DEVI void phase_final(const Params& P, const int wid) {
    const int lane = lane_id_opaque(), gw = blockIdx.x * (NT / 64) + wid, ngw = (gridDim.x * NT) >> 6;
    const float* SS = (const float*)(P.ws + WS_SS); const bf16_t* T = (const bf16_t*)(P.ws + WS_M1);
    constexpr int RF = 4;
    for (int r = gw * RF; r < MROWS; r += RF * ngw) {
        float4 sv[16];
#pragma unroll
        for (int j = 0; j < 16; ++j) sv[j] = *(const float4*)(SS + (size_t)j * MROWS + r);
        uint4 tw[RF][2]; float4 xa[RF][2], xb[RF][2];
#pragma unroll
        for (int q = 0; q < RF; ++q)
#pragma unroll
            for (int j = 0; j < 2; ++j) { const int c = j * 512 + lane * 8; const size_t o = (size_t)(r + q) * DM + c;
                tw[q][j] = *(const uint4*)(T + o); { typedef float f4v_ __attribute__((ext_vector_type(4))); const f4v_ t0_ = __builtin_nontemporal_load((const f4v_*)(P.x + o)), t1_ = __builtin_nontemporal_load((const f4v_*)(P.x + o + 4)); xa[q][j] = make_float4(t0_[0], t0_[1], t0_[2], t0_[3]); xb[q][j] = make_float4(t1_[0], t1_[1], t1_[2], t1_[3]); } }
        float ss[RF] = {0.f, 0.f, 0.f, 0.f};
#pragma unroll
        for (int j = 0; j < 16; ++j) { ss[0] += sv[j].x; ss[1] += sv[j].y; ss[2] += sv[j].z; ss[3] += sv[j].w; }
#pragma unroll
        for (int q = 0; q < RF; ++q) { const float rs = rsqrtf(ss[q] * (1.f / DM) + RMS_EPS); float* orow = P.out + (size_t)(r + q) * DM;
#pragma unroll
            for (int j = 0; j < 2; ++j) { const int c = j * 512 + lane * 8; const float4 g0 = *(const float4*)(P.norm_post + c), g1 = *(const float4*)(P.norm_post + c + 4);
                const uint4 t4 = tw[q][j]; const float4 x0 = xa[q][j], x1 = xb[q][j]; float4 o0, o1;
                o0.x = x0.x + __uint_as_float(t4.x << 16) * rs * g0.x; o0.y = x0.y + __uint_as_float(t4.x & 0xffff0000u) * rs * g0.y; o0.z = x0.z + __uint_as_float(t4.y << 16) * rs * g0.z; o0.w = x0.w + __uint_as_float(t4.y & 0xffff0000u) * rs * g0.w;
                o1.x = x1.x + __uint_as_float(t4.z << 16) * rs * g1.x; o1.y = x1.y + __uint_as_float(t4.z & 0xffff0000u) * rs * g1.y; o1.z = x1.z + __uint_as_float(t4.w << 16) * rs * g1.z; o1.w = x1.w + __uint_as_float(t4.w & 0xffff0000u) * rs * g1.w;
                { typedef float f4v_ __attribute__((ext_vector_type(4))); const f4v_ s0_ = {o0.x, o0.y, o0.z, o0.w}, s1_ = {o1.x, o1.y, o1.z, o1.w}; __builtin_nontemporal_store(s0_, (f4v_*)(orow + c)); __builtin_nontemporal_store(s1_, (f4v_*)(orow + c + 4)); } } }
    }
}

DEVI void tree_barrier(unsigned* ctl, const int wid) {
    asm volatile("s_waitcnt vmcnt(0) lgkmcnt(0)" ::: "memory");
    __builtin_amdgcn_s_barrier();
    if (wid == 0 && lane_id() == 0) {
        __builtin_amdgcn_fence(__ATOMIC_RELEASE, "agent");
        const unsigned G = gridDim.x, ng = G < 16u ? G : 16u, g = blockIdx.x % ng, gsz = G / ng + (g < G % ng ? 1u : 0u);
        const unsigned old = __hip_atomic_fetch_add(ctl + g * 32, 1u, __ATOMIC_RELAXED, __HIP_MEMORY_SCOPE_AGENT);
        if (old == gsz - 1u) {
            const unsigned o2 = __hip_atomic_fetch_add(ctl + 512, 1u, __ATOMIC_RELAXED, __HIP_MEMORY_SCOPE_AGENT);
            if (o2 == ng - 1u) __hip_atomic_store(ctl + 544, 1u, __ATOMIC_RELAXED, __HIP_MEMORY_SCOPE_AGENT);
        }
        while (__hip_atomic_load(ctl + 544, __ATOMIC_RELAXED, __HIP_MEMORY_SCOPE_AGENT) == 0u) __builtin_amdgcn_s_sleep(1);
        __builtin_amdgcn_fence(__ATOMIC_ACQUIRE, "agent");
    }
    __builtin_amdgcn_s_barrier();
}

constexpr int LDS_BYTES = 163840;
__global__ void __launch_bounds__(NT, 2) fwd_kernel(Params P) {
    extern __shared__ __attribute__((aligned(16))) unsigned char lds_raw[];
    float* lds = (float*)lds_raw;
    PG8_LAS unsigned char* ring = (PG8_LAS unsigned char*)lds_raw;
    __builtin_assume(__builtin_amdgcn_workitem_id_y() == 0); __builtin_assume(__builtin_amdgcn_workitem_id_z() == 0);
    cg::grid_group grid = cg::this_grid();
    const int wid = __builtin_amdgcn_readfirstlane(threadIdx.x >> 6);
    const int lo = P.ph_lo, hi = P.ph_hi;
#define IN(k) (lo <= (k) && (k) < hi)
#define SEAM0() do { if (IN(0) && IN(1)) { asm volatile("s_waitcnt vmcnt(0) lgkmcnt(0)" ::: "memory"); grid.sync(); } } while (0)
#define SEAM(k) do { if (IN(k) && IN((k) + 1)) tree_barrier((unsigned*)(P.ws + WS_CTL) + (k) * 1024, wid); } while (0)
    if (IN(0)) { if (blockIdx.x == 0) { unsigned* ctl = (unsigned*)(P.ws + WS_CTL); for (int i = wid * 64 + lane_id(); i < 8 * 1024; i += NT) ctl[i] = 0u; }
        phase_prep(P, lds); }
    SEAM0();
    if (IN(1)) { if (blockIdx.x & 8) { for (int i_ = 0; i_ < 2; ++i_) __builtin_amdgcn_s_sleep(127); }
        pg8::Gemm g{(const bf16_t*)(P.ws + WS_U), (const bf16_t*)(P.ws + WS_WIN), MROWS, 5888, DM}; pg8::StaticOrder S; S.init(MROWS, 5888, (int)gridDim.x, (int)blockIdx.x);
        pg8::EpiProj E{(bf16_t*)(P.ws + WS_ATT), (bf16_t*)(P.ws + WS_Z), (bf16_t*)(P.ws + WS_MRG), (float*)(P.ws + WS_G)};
        const int ksplit = 1 + (int)(((blockIdx.x >> 3) + (blockIdx.x & 7) * 3) % 22);
        S.i1 = ksplit; pg8::gemm_phase<pg8::EpiProj, pg8::StaticOrder, true, true>(ring, g, S, E, wid);
        att::phase_gates(P, (att::lchar*)lds_raw, wid);
        S.i0 = ksplit; S.i1 = 1 << 30; pg8::gemm_phase<pg8::EpiProj, pg8::StaticOrder, true, true>(ring, g, S, E, wid); }
    SEAM(1);
    if (IN(2)) { if (!IN(1)) att::phase_gates(P, (att::lchar*)lds_raw, wid); att::phase_compress(P, (att::lchar*)lds_raw, wid); }
    SEAM(2);
    if (IN(3)) att::phase_attention(P, (att::lchar*)lds_raw, wid);
    SEAM(3);
    if (IN(4)) { pg8::Gemm g{(const bf16_t*)(P.ws + WS_Y), (const bf16_t*)(P.ws + WS_WA), MROWS, 1024, 1024}; pg8::StaticOrder S; S.init(MROWS, 1024, (int)gridDim.x, (int)blockIdx.x);
        pg8::EpiMG E{(const bf16_t*)(P.ws + WS_MRG), (bf16_t*)(P.ws + WS_MM)};
        pg8::gemm_phase<pg8::EpiMG, pg8::StaticOrder, true, true>(ring, g, S, E, wid); }
    SEAM(5);
    const bool fuse_final = (gridDim.x == 256) && IN(6) && IN(7);
    if (fuse_final) { pg8::Gemm g{(const bf16_t*)(P.ws + WS_MM), (const bf16_t*)(P.ws + WS_WO), MROWS, 1024, 1024}; pg8::StaticOrder S; S.init(MROWS, 1024, (int)gridDim.x, (int)blockIdx.x);
        pg8::EpiFinal E{P.x, P.norm_post, P.out, (float*)(P.ws + WS_SS), (unsigned*)(P.ws + WS_CTL) + 7 * 1024};
        pg8::gemm_phase<pg8::EpiFinal, pg8::StaticOrder, true, true>(ring, g, S, E, wid); }
    else {
    if (IN(6)) { pg8::Gemm g{(const bf16_t*)(P.ws + WS_MM), (const bf16_t*)(P.ws + WS_WO), MROWS, 1024, 1024}; pg8::StaticOrder S; S.init(MROWS, 1024, (int)gridDim.x, (int)blockIdx.x);
            pg8::EpiOut E{(bf16_t*)(P.ws + WS_M1), (float*)(P.ws + WS_SS)};
            pg8::gemm_phase<pg8::EpiOut, pg8::StaticOrder, true, true>(ring, g, S, E, wid); }
        SEAM(6);
        if (IN(7)) phase_final(P, wid);
    }
#undef IN
#undef SEAM
}

extern "C" void kernel_launch(void* const* d_in, const int* in_sizes, int n_in, void* d_out, int out_size, void* d_ws, size_t ws_size, hipStream_t stream) {
    static int grid = 0;
    if (grid == 0) {
        if (n_in != 13 || out_size != MROWS * DM || ws_size < WS_END) { fprintf(stderr, "kernel_launch: unexpected shapes (n_in %d out %d ws %zu)\n", n_in, out_size, ws_size); grid = -1; return; }
        int dev = 0, cus = 0, per_cu = 0;
        (void)hipGetDevice(&dev); (void)hipDeviceGetAttribute(&cus, hipDeviceAttributeMultiprocessorCount, dev);
        if (hipFuncSetAttribute((const void*)fwd_kernel, hipFuncAttributeMaxDynamicSharedMemorySize, LDS_BYTES) != hipSuccess) { fprintf(stderr, "kernel_launch: hipFuncSetAttribute failed\n"); grid = -1; return; }
        (void)hipOccupancyMaxActiveBlocksPerMultiprocessor(&per_cu, (const void*)fwd_kernel, NT, LDS_BYTES);
        if (per_cu < 1) { fprintf(stderr, "kernel_launch: occupancy query says %d blocks per CU\n", per_cu); }
        (void)hipGetLastError();
        grid = cus;
    }
    if (grid < 0) return;
    Params p{};
    p.x = (const float*)d_in[0]; p.norm_pre = (const float*)d_in[1]; p.w_in = (const float*)d_in[2];
    p.pe_k = (const float*)d_in[3]; p.w1_k = (const float*)d_in[4]; p.w2_k = (const float*)d_in[5];
    p.pe_v = (const float*)d_in[6]; p.w1_v = (const float*)d_in[7]; p.w2_v = (const float*)d_in[8];
    p.w_a = (const float*)d_in[9]; p.w_b = (const float*)d_in[10]; p.w_o = (const float*)d_in[11]; p.norm_post = (const float*)d_in[12];
    p.out = (float*)d_out; p.ws = (unsigned char*)d_ws;
#if MK_N_LAUNCHES == 1
    p.ph_lo = 0; p.ph_hi = NPHASE;
    void* args[] = {&p};
    hipError_t e = hipLaunchCooperativeKernel((const void*)fwd_kernel, dim3(grid), dim3(NT), args, LDS_BYTES, stream);
    if (e != hipSuccess) fprintf(stderr, "cooperative launch failed: %s (grid %d)\n", hipGetErrorString(e), grid);
#else
    for (int ph = 0; ph < 8; ++ph) { p.ph_lo = ph; p.ph_hi = ph + 1; hipLaunchKernelGGL(fwd_kernel, dim3(grid), dim3(NT), LDS_BYTES, stream, p); }
#endif
}
```
